# Optimizing an MI355X kernel written in HIP

```python
import jax, jax.numpy as jnp
from jax import lax
import numpy as np

D_MODEL = 1024
BATCH = 8
SEQ = 8192
DEPTH = 2

CHUNK = 64
PLE_DIM = 256
D_FF = 2816
CONV_W = 4
RET_HEADS = 4
RET_DK = 64
RET_DV = 64
RET_W = RET_HEADS * RET_DV
LRU_W = 384
LRU_BLOCKS = 6
LRU_BLOCK = LRU_W // LRU_BLOCKS
LRU_C = 8.0
GDN_HEADS = 6
GDN_DK = 64
GDN_DV = 64
GDN_W = GDN_HEADS * GDN_DV
D_MIX = RET_W + LRU_W + GDN_W
IN_WIDTHS = (RET_W, RET_W, RET_W, RET_W, LRU_W, LRU_W, GDN_W, GDN_W, GDN_W, GDN_W, GDN_HEADS, GDN_HEADS)
D_IN = sum(IN_WIDTHS)
ROPE_THETA = 10000.0
ALPHA = (2 * DEPTH) ** 0.25
BETA_INIT = (8 * DEPTH) ** -0.25
LN_EPS = 1e-5

kernel_name = 'hybrid_retention_rglru_gdn_macaron_deepnorm'


def layer_norm(x, g, b):
    xf = x.astype(jnp.float32)
    mu = jnp.mean(xf, -1, keepdims=True)
    var = jnp.mean(jnp.square(xf - mu), -1, keepdims=True)
    return ((xf - mu) * lax.rsqrt(var + LN_EPS) * g + b).astype(x.dtype)


def head_norm(t, eps=1e-5):
    mu = jnp.mean(t, -1, keepdims=True)
    return (t - mu) * lax.rsqrt(jnp.var(t, -1, keepdims=True) + eps)


def rms_norm(t, g, eps=1e-6):
    return t * lax.rsqrt(jnp.mean(t * t, -1, keepdims=True) + eps) * g


def l2_normalize(t, eps=1e-6):
    return t * lax.rsqrt(jnp.sum(t * t, -1, keepdims=True) + eps)


def swiglu(x, w_gate, w_up, w_down):
    return (jax.nn.silu(x @ w_gate) * (x @ w_up)) @ w_down


def causal_depthwise_conv(x, w, b=None):
    K = w.shape[0]
    S = x.shape[1]
    xp = jnp.pad(x, ((0, 0), (K - 1, 0), (0, 0)))
    y = sum(w[k] * xp[:, k:k + S] for k in range(K))
    return y if b is None else y + b


def rotary(t, positions):
    half = t.shape[-1] // 2
    inv_freq = ROPE_THETA ** (-jnp.arange(half, dtype=jnp.float32) / half)
    ang = positions.astype(jnp.float32)[..., None] * inv_freq
    cos = jnp.cos(ang)[:, :, None, :]
    sin = jnp.sin(ang)[:, :, None, :]
    t1, t2 = t[..., :half], t[..., half:]
    return jnp.concatenate([t1 * cos - t2 * sin, t2 * cos + t1 * sin], -1)


def retention_chunked(q, k, v, positions):
    B, S, H, _ = q.shape
    N = S // CHUNK
    q = rotary(q, positions) * RET_DK ** -0.5
    k = rotary(k, positions)
    log_gamma = jnp.log1p(-jnp.exp2(-5.0 - jnp.arange(H, dtype=jnp.float32)))
    idx = jnp.arange(CHUNK, dtype=jnp.float32)
    intra = jnp.exp(jnp.abs(idx[:, None] - idx[None, :])[None] * log_gamma[:, None, None])
    cross = jnp.exp((idx + 1.0)[None] * log_gamma[:, None])
    tail = jnp.exp((CHUNK - 1.0 - idx)[None] * log_gamma[:, None])
    chunk_decay = jnp.exp(CHUNK * log_gamma)
    qc = q.reshape(B, N, CHUNK, H, RET_DK)
    kc = k.reshape(B, N, CHUNK, H, RET_DK)
    vc = v.reshape(B, N, CHUNK, H, RET_DV)
    scores = jnp.einsum('bnihd,bnjhd->bnhij', qc, kc) * intra
    o_intra = jnp.einsum('bnhij,bnjhe->bnihe', scores, vc)
    kv = jnp.einsum('bnjhd,hj,bnjhe->nbhde', kc, tail, vc)

    def step(state, kv_n):
        return state * chunk_decay[None, :, None, None] + kv_n, state

    _, states = lax.scan(step, jnp.zeros((B, H, RET_DK, RET_DV), jnp.float32), kv)
    o_cross = jnp.einsum('bnihd,hi,nbhde->bnihe', qc, cross, states)
    return (o_intra + o_cross).reshape(B, S, H, RET_DV)


def rg_lru(x, conv_w, conv_b, w_a, b_a, w_x, b_x, lam):
    B, S, _ = x.shape
    x = causal_depthwise_conv(x, conv_w, conv_b)
    xb = x.reshape(B, S, LRU_BLOCKS, LRU_BLOCK)
    r = jax.nn.sigmoid(jnp.einsum('bsgi,gij->bsgj', xb, w_a).reshape(B, S, LRU_W) + b_a)
    i = jax.nn.sigmoid(jnp.einsum('bsgi,gij->bsgj', xb, w_x).reshape(B, S, LRU_W) + b_x)
    log_a = LRU_C * r * jax.nn.log_sigmoid(lam)
    a = jnp.exp(log_a)
    b = jnp.sqrt(-jnp.expm1(2.0 * log_a)) * (i * x)

    def combine(left, right):
        a1, b1 = left
        a2, b2 = right
        return a1 * a2, a2 * b1 + b2

    _, h = lax.associative_scan(combine, (a, b), axis=1)
    return h


def gated_delta_chunked(q, k, v, g, beta):
    B, S, H, DK = q.shape
    DV = v.shape[-1]
    N = S // CHUNK

    def to_chunks(t):
        return jnp.moveaxis(t.reshape(B, N, CHUNK, H, *t.shape[3:]), 3, 2)

    q = to_chunks(q) * DK ** -0.5
    k = to_chunks(k)
    v = to_chunks(v)
    g = to_chunks(g)
    beta = to_chunks(beta)
    gc = jnp.cumsum(g, axis=-1)
    incl = jnp.tril(jnp.ones((CHUNK, CHUNK), bool))
    strict = jnp.tril(jnp.ones((CHUNK, CHUNK), bool), -1)
    decay = jnp.where(incl, jnp.exp(jnp.minimum(gc[..., :, None] - gc[..., None, :], 0.0)), 0.0)
    kk = jnp.einsum('bnhid,bnhjd->bnhij', k, k)
    a_mat = jnp.where(strict, beta[..., :, None] * kk * decay, 0.0) + jnp.eye(CHUNK, dtype=jnp.float32)
    rhs = jnp.concatenate([v * beta[..., None], k * (beta * jnp.exp(gc))[..., None]], -1)
    sol = lax.linalg.triangular_solve(a_mat, rhs, left_side=True, lower=True, unit_diagonal=True)
    u, w = sol[..., :DV], sol[..., DV:]
    qk = jnp.einsum('bnhid,bnhjd->bnhij', q, k) * decay
    q_dec = q * jnp.exp(gc)[..., None]
    g_last = gc[..., -1]
    k_tail = k * jnp.exp(g_last[..., None] - gc)[..., None]
    xs = (jnp.moveaxis(u, 1, 0), jnp.moveaxis(w, 1, 0), jnp.moveaxis(qk, 1, 0),
          jnp.moveaxis(q_dec, 1, 0), jnp.moveaxis(k_tail, 1, 0), jnp.moveaxis(g_last, 1, 0))

    def step(state, inp):
        u_n, w_n, qk_n, qd_n, kt_n, gl_n = inp
        v_new = u_n - jnp.einsum('bhcd,bhde->bhce', w_n, state)
        o = jnp.einsum('bhcd,bhde->bhce', qd_n, state) + jnp.einsum('bhij,bhje->bhie', qk_n, v_new)
        state = state * jnp.exp(gl_n)[..., None, None] + jnp.einsum('bhcd,bhce->bhde', kt_n, v_new)
        return state, o

    _, o = lax.scan(step, jnp.zeros((B, H, DK, DV), jnp.float32), xs)
    return jnp.transpose(o, (1, 0, 3, 2, 4)).reshape(B, S, H, DV)


def hybrid_mixer(x, positions, w_in, ret_norm_g, lru_conv_w, lru_conv_b, lru_w_a, lru_b_a,
                 lru_w_x, lru_b_x, lru_lambda, gdn_conv_w, gdn_a_log, gdn_dt_bias, gdn_norm_g, w_out):
    B, S, _ = x.shape
    h = (x @ w_in).astype(jnp.float32)
    splits = np.cumsum(IN_WIDTHS)[:-1].tolist()
    q_r, k_r, v_r, g_r, x_l, gate_l, q_g, k_g, v_g, z_g, a_g, b_g = jnp.split(h, splits, axis=-1)

    o_r = retention_chunked(q_r.reshape(B, S, RET_HEADS, RET_DK), k_r.reshape(B, S, RET_HEADS, RET_DK),
                            v_r.reshape(B, S, RET_HEADS, RET_DV), positions)
    o_r = head_norm(o_r).reshape(B, S, RET_W) * ret_norm_g * jax.nn.silu(g_r)

    o_l = rg_lru(x_l, lru_conv_w, lru_conv_b, lru_w_a, lru_b_a, lru_w_x, lru_b_x, lru_lambda) * jax.nn.gelu(gate_l)

    qkv = jax.nn.silu(causal_depthwise_conv(jnp.concatenate([q_g, k_g, v_g], -1), gdn_conv_w))
    q_g, k_g, v_g = jnp.split(qkv, 3, axis=-1)
    q_g = l2_normalize(q_g.reshape(B, S, GDN_HEADS, GDN_DK))
    k_g = l2_normalize(k_g.reshape(B, S, GDN_HEADS, GDN_DK))
    v_g = v_g.reshape(B, S, GDN_HEADS, GDN_DV)
    beta = jax.nn.sigmoid(b_g)
    g = -jnp.exp(gdn_a_log) * jax.nn.softplus(a_g + gdn_dt_bias)
    o_g = gated_delta_chunked(q_g, k_g, v_g, g, beta)
    o_g = (rms_norm(o_g, gdn_norm_g) * jax.nn.silu(z_g.reshape(B, S, GDN_HEADS, GDN_DV))).reshape(B, S, GDN_W)

    o = jnp.concatenate([o_r, o_l, o_g], -1).astype(x.dtype)
    return o @ w_out


def setup_inputs(seed: int = 0) -> dict:
    key = jax.random.key(seed)
    counter = [0]

    def nk():
        counter[0] += 1
        return jax.random.fold_in(key, counter[0])

    f32 = jnp.float32
    L = DEPTH

    def nrm(shape, fan_in, scale=1.0):
        return jax.random.normal(nk(), shape, f32) * (scale * fan_in ** -0.5)

    def gain(shape):
        return 1.0 + 0.02 * jax.random.normal(nk(), shape, f32)

    def bias(shape):
        return 0.02 * jax.random.normal(nk(), shape, f32)

    x = jax.random.normal(nk(), (BATCH, SEQ, D_MODEL), f32)
    p = jax.random.normal(nk(), (DEPTH, BATCH, SEQ, PLE_DIM), f32)
    start = jax.random.randint(nk(), (BATCH, 1), 0, 4096, jnp.int32)
    positions = start + jnp.arange(SEQ, dtype=jnp.int32)[None, :]
    a0 = jax.random.uniform(nk(), (L, LRU_W), f32, 0.9, 0.999)
    lru_lambda = jnp.log(a0) - jnp.log1p(-a0)
    gdn_a_log = jnp.log(jax.random.uniform(nk(), (L, GDN_HEADS), f32, 1.0, 16.0))
    dt = jnp.exp(jax.random.uniform(nk(), (L, GDN_HEADS), f32, np.log(1e-3), np.log(1e-1)))
    gdn_dt_bias = dt + jnp.log(-jnp.expm1(-dt))
    return {
        'x': x,
        'p': p,
        'positions': positions,
        'ln_ffn1_g': gain((L, D_MODEL)),
        'ln_ffn1_b': bias((L, D_MODEL)),
        'ffn1_w_gate': nrm((L, D_MODEL, D_FF), D_MODEL),
        'ffn1_w_up': nrm((L, D_MODEL, D_FF), D_MODEL),
        'ffn1_w_down': nrm((L, D_FF, D_MODEL), D_FF, BETA_INIT),
        'w_in': nrm((L, D_MODEL, D_IN), D_MODEL),
        'ret_norm_g': gain((L, RET_W)),
        'lru_conv_w': nrm((L, CONV_W, LRU_W), CONV_W),
        'lru_conv_b': bias((L, LRU_W)),
        'lru_w_a': nrm((L, LRU_BLOCKS, LRU_BLOCK, LRU_BLOCK), LRU_BLOCK),
        'lru_b_a': bias((L, LRU_W)),
        'lru_w_x': nrm((L, LRU_BLOCKS, LRU_BLOCK, LRU_BLOCK), LRU_BLOCK),
        'lru_b_x': bias((L, LRU_W)),
        'lru_lambda': lru_lambda,
        'gdn_conv_w': nrm((L, CONV_W, 3 * GDN_W), CONV_W),
        'gdn_a_log': gdn_a_log,
        'gdn_dt_bias': gdn_dt_bias,
        'gdn_norm_g': gain((L, GDN_DV)),
        'w_out': nrm((L, D_MIX, D_MODEL), D_MIX, BETA_INIT),
        'ln_mix_g': gain((L, D_MODEL)),
        'ln_mix_b': bias((L, D_MODEL)),
        'ffn2_w_gate': nrm((L, D_MODEL, D_FF), D_MODEL),
        'ffn2_w_up': nrm((L, D_MODEL, D_FF), D_MODEL),
        'ffn2_w_down': nrm((L, D_FF, D_MODEL), D_FF, BETA_INIT),
        'ple_w_gate': nrm((L, D_MODEL, D_MODEL), D_MODEL),
        'ple_w_proj': nrm((L, PLE_DIM, D_MODEL), PLE_DIM, BETA_INIT),
        'ln_ffn2_g': gain((L, D_MODEL)),
        'ln_ffn2_b': bias((L, D_MODEL)),
    }


def reference(x, p, positions, ln_ffn1_g, ln_ffn1_b, ffn1_w_gate, ffn1_w_up, ffn1_w_down,
              w_in, ret_norm_g, lru_conv_w, lru_conv_b, lru_w_a, lru_b_a, lru_w_x, lru_b_x, lru_lambda,
              gdn_conv_w, gdn_a_log, gdn_dt_bias, gdn_norm_g, w_out, ln_mix_g, ln_mix_b,
              ffn2_w_gate, ffn2_w_up, ffn2_w_down, ple_w_gate, ple_w_proj, ln_ffn2_g, ln_ffn2_b):
    for i in range(DEPTH):
        x = layer_norm(ALPHA * x + 0.5 * swiglu(x, ffn1_w_gate[i], ffn1_w_up[i], ffn1_w_down[i]),
                       ln_ffn1_g[i], ln_ffn1_b[i])
        mix = hybrid_mixer(x, positions, w_in[i], ret_norm_g[i], lru_conv_w[i], lru_conv_b[i],
                           lru_w_a[i], lru_b_a[i], lru_w_x[i], lru_b_x[i], lru_lambda[i],
                           gdn_conv_w[i], gdn_a_log[i], gdn_dt_bias[i], gdn_norm_g[i], w_out[i])
        x = layer_norm(ALPHA * x + mix, ln_mix_g[i], ln_mix_b[i])
        ffn = 0.5 * swiglu(x, ffn2_w_gate[i], ffn2_w_up[i], ffn2_w_down[i])
        ple = jax.nn.sigmoid(x @ ple_w_gate[i]) * (p[i] @ ple_w_proj[i])
        x = layer_norm(ALPHA * x + ffn + ple, ln_ffn2_g[i], ln_ffn2_b[i])
    return x
```

```cpp
#include <hip/hip_runtime.h>
#include <hip/hip_cooperative_groups.h>
#include <cstdio>
#include <cstdint>
namespace cg = cooperative_groups;

#ifndef ONE_LAUNCH
#define ONE_LAUNCH 1
#endif

#define LAS __attribute__((address_space(3)))
#define GAS __attribute__((address_space(1)))
#define CAS __attribute__((address_space(4)))
typedef unsigned short bf16_t;
typedef short bf16x8 __attribute__((ext_vector_type(8)));
typedef short bf16x4 __attribute__((ext_vector_type(4)));
typedef float f32x4 __attribute__((ext_vector_type(4)));
typedef float f32x2 __attribute__((ext_vector_type(2)));
typedef unsigned u32x4 __attribute__((ext_vector_type(4)));
typedef unsigned u32x2 __attribute__((ext_vector_type(2)));

constexpr int M = 65536, DM = 1024, DFF = 2816, DIN = 3340, DINP = 3584, SEQL = 8192, NCH = 128;
constexpr int XBLD = 1280;
constexpr float ALPHA = 1.41421356237309515f;
constexpr float LN_EPS = 1e-5f;
constexpr int C_RQ = 0, C_RK = 256, C_RV = 512, C_RG = 768, C_LX = 1024, C_LG = 1408, C_GQ = 1792, C_GK = 2176, C_GV = 2560, C_GZ = 2944, C_GA = 3328, C_GB = 3334;
constexpr int O_R = 0, O_L = 256, O_G = 640;

constexpr size_t MiB = 1u << 20;
constexpr size_t WS_WT = 1 * MiB;
constexpr size_t WT_GU1 = 0, WT_D1 = WT_GU1 + (size_t)5632 * 1024 * 2, WT_IN = WT_D1 + (size_t)1024 * 2816 * 2, WT_OUT = WT_IN + (size_t)3584 * 1024 * 2,
                 WT_GU2 = WT_OUT + (size_t)1024 * 1024 * 2, WT_D2 = WT_GU2 + (size_t)5632 * 1024 * 2, WT_PLE = WT_D2 + (size_t)1024 * 2816 * 2, WT_LAYER = WT_PLE + (size_t)2048 * 1280 * 2;
static_assert(2 * WT_LAYER <= 96 * MiB, "weights");
constexpr size_t WS_XB = 100 * MiB;
constexpr size_t WS_BIG = 324 * MiB;
constexpr size_t WS_O = 772 * MiB;
constexpr size_t WS_END = 900 * MiB;
constexpr size_t NUG = 3072, NUR = 2048;
constexpr size_t SC_GW = 0, SC_GQK = SC_GW + NUG * 8192, SC_GQ = SC_GQK + NUG * 8192, SC_GKT = SC_GQ + NUG * 8192, SC_GU = SC_GKT + NUG * 8192, SC_GVEC = SC_GU + NUG * 8192,
                 SC_RSC = SC_GVEC + NUG * 1024, SC_RQX = SC_RSC + NUR * 8192, SC_RKT = SC_RQX + NUR * 8192, SC_RVT = SC_RKT + NUR * 8192,
                 SC_LP2 = SC_RVT + NUR * 8192, SC_LSH = SC_LP2 + (size_t)4 * 8192 * 384 * 2, SC_LSA = SC_LSH + (size_t)4 * 128 * 384 * 4, SC_END = SC_LSA + (size_t)4 * 128 * 384 * 4;
static_assert(SC_END <= 224 * MiB, "mixer scratch");

constexpr int LDS_BYTES = 147456;
constexpr int NPH = 27;

struct Args { const void* in[31]; float* out; unsigned char* ws; int ph_lo, ph_hi; };

__device__ __forceinline__ unsigned f2bf(float f) { unsigned u = __builtin_bit_cast(unsigned, f); return (u + 0x7fffu + ((u >> 16) & 1u)) >> 16; }
__device__ __forceinline__ unsigned pk2(float lo, float hi) { return f2bf(lo) | (f2bf(hi) << 16); }
__device__ __forceinline__ float bf2f(bf16_t u) { return __builtin_bit_cast(float, (unsigned)u << 16); }
__device__ __forceinline__ float sigmoidf_(float x) { return __builtin_amdgcn_rcpf(1.0f + __expf(-x)); }
__device__ __forceinline__ float siluf_(float x) { return x * __builtin_amdgcn_rcpf(1.0f + __expf(-x)); }
__device__ __forceinline__ float log1p_pos(float e) { const float z = e * __builtin_amdgcn_rcpf(2.0f + e), z2 = z * z; const float sr = 2.0f * z * (1.0f + z2 * (0.333333333f + z2 * (0.2f + z2 * (0.142857143f + z2 * 0.111111111f)))); return e < 0.25f ? sr : __logf(1.0f + e); }
__device__ __forceinline__ float one_minus_exp(float y) { const float sr = -y * (1.0f + y * (0.5f + y * (0.166666667f + y * (0.0416666667f + y * 0.00833333333f)))); return y > -0.1f ? sr : 1.0f - __expf(y); }
__device__ __forceinline__ float gelu_tanh(float x) { const float u = 0.7978845608028654f * (x + 0.044715f * x * x * x); const float e = __expf(2.0f * u); const float th = 1.0f - 2.0f * __builtin_amdgcn_rcpf(e + 1.0f); return 0.5f * x * (1.0f + th); }
__device__ __forceinline__ bf16x8 pack8(f32x4 a, f32x4 b) { u32x4 w; w.x = pk2(a.x, a.y); w.y = pk2(a.z, a.w); w.z = pk2(b.x, b.y); w.w = pk2(b.z, b.w); return __builtin_bit_cast(bf16x8, w); }
__device__ __forceinline__ f32x4 unpack4(bf16x4 v) { f32x4 r; r.x = bf2f((bf16_t)v.x); r.y = bf2f((bf16_t)v.y); r.z = bf2f((bf16_t)v.z); r.w = bf2f((bf16_t)v.w); return r; }
__device__ __forceinline__ float wave_sum(float v) {
#pragma unroll
    for (int o = 1; o < 64; o <<= 1) v += __shfl_xor(v, o);
    return v;
}
__device__ __forceinline__ int frag_off(int row, int col) { const int mt = row >> 4, r = row & 15, ks = col >> 5, hi = (col >> 4) & 1, q = (col >> 2) & 3, lo = col & 3; return ((mt * 2 + ks) * 64 + q * 16 + r) * 8 + hi * 4 + lo; }
__device__ __forceinline__ int cfrag_off(int c, int e) { const int mt = c >> 4, q = (c >> 2) & 3, j = c & 3; return ((mt * 4 + (e >> 4)) * 64 + q * 16 + (e & 15)) * 4 + j; }
__device__ __forceinline__ int bfrag_off(int c, int e) { const int ks = c >> 5, hi = (c >> 4) & 1, q = (c >> 2) & 3, lo = c & 3; return ((ks * 4 + (e >> 4)) * 64 + q * 16 + (e & 15)) * 8 + hi * 4 + lo; }

__constant__ double INVF_REV[32] = {1.59154943091895346e-01, 1.19349370211248862e-01, 8.94994016088910133e-02, 6.71150830052272551e-02, 5.03292121044870353e-02, 3.77415847174197711e-02, 2.83021958306233987e-02, 2.12236527647776604e-02, 1.59154943091895339e-02, 1.19349370211248862e-02, 8.94994016088910237e-03, 6.71150830052272534e-03, 5.03292121044870370e-03, 3.77415847174197719e-03, 2.83021958306233987e-03, 2.12236527647776622e-03, 1.59154943091895356e-03, 1.19349370211248849e-03, 8.94994016088910237e-04, 6.71150830052272599e-04, 5.03292121044870326e-04, 3.77415847174197741e-04, 2.83021958306233954e-04, 2.12236527647776605e-04, 1.59154943091895351e-04, 1.19349370211248862e-04, 8.94994016088910182e-05, 6.71150830052272545e-05, 5.03292121044870354e-05, 3.77415847174197768e-05, 2.83021958306233961e-05, 2.12236527647776592e-05};

namespace pg8 {
constexpr int BM = 256, BK = 64, HALF = 128, HTB = HALF * BK * 2, STAGE_BYTES = 8 * HTB, NXCD = 8, WGM = 8;
__device__ __forceinline__ int lds_byte(int r, int c) { const int st = (r >> 4) * 2 + (c >> 5), rr = r & 15, cc = c & 31, ob = rr * 64 + cc * 2; return st * 1024 + (ob ^ (((ob >> 9) & 1) << 5)); }
__device__ __forceinline__ void stage_rc(int b, int& R, int& C) { const int st = b / 1024, sb = b % 1024, swz = sb ^ (((sb >> 9) & 1) << 5); R = (st >> 1) * 16 + swz / 64; C = (st & 1) * 32 + (swz % 64) / 2; }
__device__ __forceinline__ int perm32(int rho) { const int n = rho >> 4, i = rho & 15; return 8 * (i >> 2) + 4 * n + (i & 3); }
struct Unit { int pm, pn; };
struct Gemm { const bf16_t* A; const bf16_t* Bt; };
struct StaticOrder {
    int nM, nN, nwg, G, c;
    __device__ void init(int M_, int N_, int G_, int c_) { nM = M_ / BM; nN = N_ / BM; nwg = nM * nN; G = G_; c = c_; }
    __device__ bool next(int i, Unit& u) const {
        const long L = (long)i * G + c; if (L >= nwg) return false;
        int wgid = (int)L; { const int q = nwg / NXCD, r = nwg % NXCD, xcd = wgid % NXCD, off = wgid / NXCD; wgid = (xcd < r ? xcd * (q + 1) : r * (q + 1) + (xcd - r) * q) + off; }
        const int nig = WGM * nN, gid = wgid / nig, fm = gid * WGM, gsz = (nM - fm) < WGM ? (nM - fm) : WGM;
        u.pm = fm + ((wgid % nig) % gsz); u.pn = (wgid % nig) / gsz; return true;
    }
};
struct EpiBf16 {
    static constexpr bool PERM = true;
    bf16_t* O; int ldc;
    __device__ __forceinline__ void operator()(const f32x4 (&acc)[2][2][4][2], const Unit& u, int wr, int wc, int fr, int fq) const {
        const int row0 = u.pm * BM + wr * 64 + fr, col0 = u.pn * BM + wc * 32 + 8 * fq;
#pragma unroll
        for (int ai = 0; ai < 2; ++ai)
#pragma unroll
            for (int m = 0; m < 4; ++m) { bf16_t* rowp = O + (size_t)(row0 + ai * HALF + m * 16) * ldc + col0;
#pragma unroll
                for (int bj = 0; bj < 2; ++bj) { const f32x4 v0 = acc[ai][bj][m][0], v1 = acc[ai][bj][m][1];
                    u32x4 w; w.x = pk2(v0[0], v0[1]); w.y = pk2(v0[2], v0[3]); w.z = pk2(v1[0], v1[1]); w.w = pk2(v1[2], v1[3]);
                    *(u32x4*)(rowp + bj * HALF) = w; } }
    }
};
template <int ACT  > struct EpiGated {
    static constexpr bool PERM = true;
    bf16_t* O; int ldc;
    __device__ __forceinline__ void operator()(const f32x4 (&acc)[2][2][4][2], const Unit& u, int wr, int wc, int fr, int fq) const {
        const int row0 = u.pm * BM + wr * 64 + fr, col0 = u.pn * HALF + wc * 32 + 8 * fq;
#pragma unroll
        for (int ai = 0; ai < 2; ++ai)
#pragma unroll
            for (int m = 0; m < 4; ++m) { bf16_t* rowp = O + (size_t)(row0 + ai * HALF + m * 16) * ldc + col0;
                float h[8];
#pragma unroll
                for (int n = 0; n < 2; ++n)
#pragma unroll
                    for (int j = 0; j < 4; ++j) { const float g = acc[ai][0][m][n][j], up = acc[ai][1][m][n][j]; const float s = __builtin_amdgcn_rcpf(1.0f + __expf(-g)); h[n * 4 + j] = (ACT == 0 ? g * s : s) * up; }
                u32x4 w; w.x = pk2(h[0], h[1]); w.y = pk2(h[2], h[3]); w.z = pk2(h[4], h[5]); w.w = pk2(h[6], h[7]);
                *(u32x4*)rowp = w; }
    }
};
struct EpiResid {
    static constexpr bool PERM = false;
    const float* resid; float* out; const bf16_t* ple; float s;
    __device__ __forceinline__ void operator()(const f32x4 (&acc)[2][2][4][2], const Unit& u, int wr, int wc, int fr, int fq) const {
        const int col0 = u.pn * BM + wc * 32 + 4 * fq;
#pragma unroll
        for (int ai = 0; ai < 2; ++ai)
#pragma unroll
            for (int m = 0; m < 4; ++m) { const size_t off = (size_t)(u.pm * BM + ai * HALF + wr * 64 + m * 16 + fr) * DM + col0;
#pragma unroll
                for (int bj = 0; bj < 2; ++bj)
#pragma unroll
                    for (int n = 0; n < 2; ++n) { const size_t o2 = off + bj * HALF + n * 16; const f32x4 x = *(const f32x4*)(resid + o2); f32x4 o = x * ALPHA + acc[ai][bj][m][n] * s;
                        if (ple) { const bf16x4 pv = *(const bf16x4*)(ple + o2); o = o + unpack4(pv); }
                        *(f32x4*)(out + o2) = o; } }
    }
};

template <int LDA, int LDB, int KK, class Epi>
__device__ __forceinline__ void gemm_phase(LAS unsigned char* lds, const int tid, const Gemm g, const StaticOrder& S, const Epi& E) {
    const int  wid = __builtin_amdgcn_readfirstlane(tid >> 6), lane = tid & 63, wr = wid >> 2, wc = wid & 3, fr = lane & 15, fq = lane >> 4;
    constexpr int nt = KK / BK;
    unsigned voffA[2], voffB[2];
#pragma unroll
    for (int i = 0; i < 2; ++i) { int R, C; stage_rc(tid * 16 + i * 8192, R, C); const int Rb = Epi::PERM ? ((R & ~31) + perm32(R & 31)) : R;
        voffA[i] = (unsigned)(R * LDA + C) * 2u; voffB[i] = (unsigned)(Rb * LDB + C) * 2u; }
    constexpr size_t kstep = (size_t)(BK * 2);
    constexpr size_t hstepA = (size_t)HALF * LDA * 2, hstepB = (size_t)HALF * LDB * 2;
    constexpr size_t tstepA = 2 * hstepA, tstepB = 2 * hstepB;
    const unsigned ldsw = (unsigned)wid * 1024u;
    const int aoff = lds_byte(wr * 64 + fr, fq * 8), boff = lds_byte(wc * 32 + fr, fq * 8);
#define PG8_SA(b, h) (((b) * 2 + (h)) * HTB)
#define PG8_SB(b, h) ((4 + (b) * 2 + (h)) * HTB)
#define PG8_STAGE(bufoff, gbase, voff) do { _Pragma("unroll") for (int _i = 0; _i < 2; ++_i) \
        __builtin_amdgcn_global_load_lds((const unsigned*)((const char*)(gbase) + (voff)[_i]), (LAS unsigned*)(lds + (bufoff) + ldsw + _i * 8192), 16, 0, 0); } while (0)
#define PG8_LDA(dst, b, h) do { _Pragma("unroll") for (int m = 0; m < 4; ++m) _Pragma("unroll") for (int k = 0; k < 2; ++k) dst[m][k] = *(const LAS bf16x8*)(lds + PG8_SA(b, h) + aoff + m * 2048 + k * 1024); } while (0)
#define PG8_LDB(dst, b, h) do { _Pragma("unroll") for (int n = 0; n < 2; ++n) _Pragma("unroll") for (int k = 0; k < 2; ++k) dst[n][k] = *(const LAS bf16x8*)(lds + PG8_SB(b, h) + boff + n * 2048 + k * 1024); } while (0)
#define PG8_MMA(ai, bj, At, Bt) do { __builtin_amdgcn_s_setprio(1); _Pragma("unroll") for (int m = 0; m < 4; ++m) _Pragma("unroll") for (int n = 0; n < 2; ++n) _Pragma("unroll") for (int k = 0; k < 2; ++k) \
        acc[ai][bj][m][n] = __builtin_amdgcn_mfma_f32_16x16x32_bf16(Bt[n][k], At[m][k], acc[ai][bj][m][n], 0, 0, 0); __builtin_amdgcn_s_setprio(0); } while (0)
#define PG8_WAIT_V(n) asm volatile("s_waitcnt vmcnt(" #n ")" ::: "memory")
#define PG8_WAIT_L(n) asm volatile("s_waitcnt lgkmcnt(" #n ")" ::: "memory")
#define PG8_BAR __builtin_amdgcn_s_barrier()
#define PG8_SCHED __builtin_amdgcn_sched_barrier(0)
    Unit cur, nxt; int ui = 0;
    if (!S.next(0, cur)) return;
    f32x4 acc[2][2][4][2];
#pragma unroll
    for (int a = 0; a < 2; ++a)
#pragma unroll
        for (int b = 0; b < 2; ++b)
#pragma unroll
            for (int m = 0; m < 4; ++m)
#pragma unroll
                for (int n = 0; n < 2; ++n) acc[a][b][m][n] = (f32x4){0.f, 0.f, 0.f, 0.f};
    bf16x8 At[4][2], B0[2][2], B1[2][2];
    const char* cA = (const char*)g.A + (size_t)cur.pm * tstepA; const char* cB = (const char*)g.Bt + (size_t)cur.pn * tstepB;
    PG8_STAGE(PG8_SB(0, 0), cB, voffB); PG8_STAGE(PG8_SB(0, 1), cB + hstepB, voffB); PG8_STAGE(PG8_SA(0, 0), cA, voffA); PG8_STAGE(PG8_SA(0, 1), cA + hstepA, voffA);
    if (wr == 1) PG8_BAR;
    PG8_WAIT_V(2); PG8_BAR;
    PG8_STAGE(PG8_SB(1, 0), cB + kstep, voffB); PG8_STAGE(PG8_SA(1, 0), cA + kstep, voffA); PG8_STAGE(PG8_SB(1, 1), cB + hstepB + kstep, voffB);
    PG8_WAIT_V(6); PG8_BAR;
    for (;;) {
        const bool has_next = S.next(ui + 1, nxt);
        const char* nA = has_next ? (const char*)g.A + (size_t)nxt.pm * tstepA : cA; const char* nB = has_next ? (const char*)g.Bt + (size_t)nxt.pn * tstepB : cB;
        for (int t = 0; t < nt; t += 2) {
            const bool last = (t == nt - 2);
            const char* a1 = cA + (size_t)(t + 1) * kstep;
            const char* a2 = last ? nA : cA + (size_t)(t + 2) * kstep; const char* b2 = last ? nB : cB + (size_t)(t + 2) * kstep;
            const char* a3 = a2 + kstep; const char* b3 = b2 + kstep;
            PG8_LDB(B0, 0, 0); PG8_LDB(B1, 0, 1); PG8_SCHED; PG8_LDA(At, 0, 0); PG8_STAGE(PG8_SA(1, 1), a1 + hstepA, voffA);
            PG8_WAIT_V(8); PG8_WAIT_L(0); PG8_BAR; PG8_MMA(0, 0, At, B0); PG8_MMA(0, 1, At, B1); PG8_BAR; PG8_SCHED;
            PG8_LDA(At, 0, 1); PG8_STAGE(PG8_SB(0, 0), b2, voffB); PG8_STAGE(PG8_SB(0, 1), b2 + hstepB, voffB); PG8_STAGE(PG8_SA(0, 0), a2, voffA);
            PG8_WAIT_V(8); PG8_WAIT_L(0); PG8_BAR; PG8_MMA(1, 0, At, B0); PG8_MMA(1, 1, At, B1); PG8_BAR; PG8_SCHED;
            PG8_LDB(B0, 1, 0); PG8_LDB(B1, 1, 1); PG8_SCHED; PG8_LDA(At, 1, 0); PG8_STAGE(PG8_SA(0, 1), a2 + hstepA, voffA);
            PG8_WAIT_V(8); PG8_WAIT_L(0); PG8_BAR; PG8_MMA(0, 0, At, B0); PG8_MMA(0, 1, At, B1); PG8_BAR; PG8_SCHED;
            PG8_LDA(At, 1, 1); PG8_STAGE(PG8_SB(1, 0), b3, voffB); PG8_STAGE(PG8_SB(1, 1), b3 + hstepB, voffB); PG8_STAGE(PG8_SA(1, 0), a3, voffA);
            PG8_WAIT_V(8); PG8_WAIT_L(0); PG8_BAR; PG8_MMA(1, 0, At, B0); PG8_MMA(1, 1, At, B1); PG8_BAR; PG8_SCHED;
        }
        if (wr == 0) PG8_BAR;
        E(acc, cur, wr, wc, fr, fq);
        if (!has_next) break;
#pragma unroll
        for (int a = 0; a < 2; ++a)
#pragma unroll
            for (int b = 0; b < 2; ++b)
#pragma unroll
                for (int m = 0; m < 4; ++m)
#pragma unroll
                    for (int n = 0; n < 2; ++n) acc[a][b][m][n] = (f32x4){0.f, 0.f, 0.f, 0.f};
        cur = nxt; cA = nA; cB = nB; ++ui;
        if (wr == 1) PG8_BAR;
    }
    PG8_WAIT_V(0);
    PG8_BAR;
#undef PG8_SA
#undef PG8_SB
#undef PG8_STAGE
#undef PG8_LDA
#undef PG8_LDB
#undef PG8_MMA
#undef PG8_WAIT_V
#undef PG8_WAIT_L
#undef PG8_BAR
#undef PG8_SCHED
}
}

struct Frame {
    LAS unsigned char* lds; float* ldsf;
    int tid, lane, wave, G, bid; GAS unsigned char* ws; const CAS struct Args* ap;
};

__device__ __forceinline__ void conv_mat(const Frame& F, const float* W, int K, int N, int Ndst, bf16_t* dst, int ldd, int kofs, int mode) {
    const int gw = F.bid * 8 + F.wave, NGW = F.G * 8;
    const int nblk = Ndst / 64, kblk = K / 8, items = nblk * kblk;
    for (int it = gw; it < items; it += NGW) {
        const int nb = it % nblk, kb = it / nblk; const int n = nb * 64 + F.lane, k0 = kb * 8;
        float v[8];
#pragma unroll
        for (int kk = 0; kk < 8; ++kk) v[kk] = (n < N) ? W[(size_t)(k0 + kk) * N + n] : 0.f;
        const int row = (mode == 0) ? n : ((n >> 7) * 256 + (n & 127) + (mode == 2 ? 128 : 0));
        u32x4 w; w.x = pk2(v[0], v[1]); w.y = pk2(v[2], v[3]); w.z = pk2(v[4], v[5]); w.w = pk2(v[6], v[7]);
        *(u32x4*)(dst + (size_t)row * ldd + kofs + k0) = w;
    }
}
__device__ __forceinline__ void p_prologue(Frame& F) {
    const int gw = F.bid * 8 + F.wave, NGW = F.G * 8;
    for (int l = 0; l < 2; ++l) {
        unsigned char* wt = (unsigned char*)(F.ws + WS_WT + (size_t)l * WT_LAYER);
        conv_mat(F, ((const float*)(const GAS float*)F.ap->in[5]) + (size_t)l * DM * DFF, DM, DFF, DFF, (bf16_t*)(wt + WT_GU1), DM, 0, 1);
        conv_mat(F, ((const float*)(const GAS float*)F.ap->in[6]) + (size_t)l * DM * DFF, DM, DFF, DFF, (bf16_t*)(wt + WT_GU1), DM, 0, 2);
        conv_mat(F, ((const float*)(const GAS float*)F.ap->in[7]) + (size_t)l * DFF * DM, DFF, DM, DM, (bf16_t*)(wt + WT_D1), DFF, 0, 0);
        conv_mat(F, ((const float*)(const GAS float*)F.ap->in[8]) + (size_t)l * DM * DIN, DM, DIN, DINP, (bf16_t*)(wt + WT_IN), DM, 0, 0);
        conv_mat(F, ((const float*)(const GAS float*)F.ap->in[21]) + (size_t)l * DM * DM, DM, DM, DM, (bf16_t*)(wt + WT_OUT), DM, 0, 0);
        conv_mat(F, ((const float*)(const GAS float*)F.ap->in[24]) + (size_t)l * DM * DFF, DM, DFF, DFF, (bf16_t*)(wt + WT_GU2), DM, 0, 1);
        conv_mat(F, ((const float*)(const GAS float*)F.ap->in[25]) + (size_t)l * DM * DFF, DM, DFF, DFF, (bf16_t*)(wt + WT_GU2), DM, 0, 2);
        conv_mat(F, ((const float*)(const GAS float*)F.ap->in[26]) + (size_t)l * DFF * DM, DFF, DM, DM, (bf16_t*)(wt + WT_D2), DFF, 0, 0);
        conv_mat(F, ((const float*)(const GAS float*)F.ap->in[27]) + (size_t)l * DM * DM, DM, DM, DM, (bf16_t*)(wt + WT_PLE), XBLD, 0, 1);
        conv_mat(F, ((const float*)(const GAS float*)F.ap->in[28]) + (size_t)l * 256 * DM, 256, DM, DM, (bf16_t*)(wt + WT_PLE), XBLD, 1024, 2);
        bf16_t* wp = (bf16_t*)(wt + WT_PLE);
        for (int it = gw * 64 + F.lane; it < 2048 * 160; it += NGW * 64) { const int row = it / 160, ch = it % 160; const bool isproj = (row >> 7) & 1; const bool z = isproj ? (ch < 128) : (ch >= 128);
            if (z) *(u32x4*)(wp + (size_t)row * XBLD + ch * 8) = (u32x4){0u, 0u, 0u, 0u}; }
    }
    const float* x = ((const float*)(const GAS float*)F.ap->in[0]);
    for (int m = gw; m < M; m += NGW) { const f32x4* xr = (const f32x4*)(x + (size_t)m * DM) + F.lane; u32x2* o = (u32x2*)(((bf16_t*)((unsigned char*)(F.ws + WS_XB))) + (size_t)m * XBLD) + F.lane;
#pragma unroll
        for (int j = 0; j < 4; ++j) { const f32x4 v = xr[64 * j]; u32x2 w; w.x = pk2(v.x, v.y); w.y = pk2(v.z, v.w); o[64 * j] = w; } }
}
__device__ __forceinline__ void p_layernorm(Frame& F, const float* g, const float* b, const float* pl) {
    const int gw = F.bid * 8 + F.wave, NGW = F.G * 8;
    f32x4 g4[4], b4[4];
#pragma unroll
    for (int j = 0; j < 4; ++j) { g4[j] = ((const f32x4*)g)[F.lane + 64 * j]; b4[j] = ((const f32x4*)b)[F.lane + 64 * j]; }
    for (int m = gw; m < M; m += NGW) {
        f32x4* xr = (f32x4*)(((float*)(GAS float*)F.ap->out) + (size_t)m * DM) + F.lane;
        f32x4 v[4]; float s = 0.f;
#pragma unroll
        for (int j = 0; j < 4; ++j) { v[j] = xr[64 * j]; s += (v[j].x + v[j].y) + (v[j].z + v[j].w); }
        const float mean = wave_sum(s) * (1.f / DM); float s2 = 0.f;
#pragma unroll
        for (int j = 0; j < 4; ++j) { v[j] = v[j] - mean; s2 += (v[j].x * v[j].x + v[j].y * v[j].y) + (v[j].z * v[j].z + v[j].w * v[j].w); }
        const float rstd = __builtin_amdgcn_rsqf(wave_sum(s2) * (1.f / DM) + LN_EPS);
        u32x2* o = (u32x2*)(((bf16_t*)((unsigned char*)(F.ws + WS_XB))) + (size_t)m * XBLD) + F.lane;
#pragma unroll
        for (int j = 0; j < 4; ++j) { const f32x4 y = v[j] * rstd * g4[j] + b4[j]; xr[64 * j] = y; u32x2 w; w.x = pk2(y.x, y.y); w.y = pk2(y.z, y.w); o[64 * j] = w; }
        if (pl) { const f32x4 pv = ((const f32x4*)(pl + (size_t)m * 256))[F.lane]; u32x2 w; w.x = pk2(pv.x, pv.y); w.y = pk2(pv.z, pv.w); o[256] = w; }
    }
}

constexpr int LS = 68;
__device__ __forceinline__ void dot_rows(const float* X, const float* Y, int iw, int j, float (&acc)[8]) {
#pragma unroll
    for (int ii = 0; ii < 8; ++ii) acc[ii] = 0.f;
#pragma unroll 4
    for (int d4 = 0; d4 < 16; ++d4) { const f32x4 y = *(const f32x4*)(Y + j * LS + 4 * d4);
#pragma unroll
        for (int ii = 0; ii < 8; ++ii) { const f32x4 x = *(const f32x4*)(X + (iw + 8 * ii) * LS + 4 * d4); acc[ii] += (x.x * y.x + x.y * y.y) + (x.z * y.z + x.w * y.w); } }
}

__device__ __forceinline__ void gdn_par_unit(Frame& F, int l, int b, int n, int h, int ul) {
    float* Q = F.ldsf; float* Kx = Q + 64 * LS; float* V = Kx + 64 * LS; float* A = V + 64 * LS; float* vec = A + 64 * LS;
    const int tid = F.tid;
    const bf16_t* hin = ((bf16_t*)(F.ws + WS_BIG)) + (size_t)b * SEQL * DINP;
    const float* cw = ((const float*)(const GAS float*)F.ap->in[17]) + (size_t)l * 4 * 1152;
    bf16_t* GW = (bf16_t*)(((unsigned char*)(F.ws + WS_XB)) + SC_GW) + (size_t)ul * 4096; bf16_t* GQK = (bf16_t*)(((unsigned char*)(F.ws + WS_XB)) + SC_GQK) + (size_t)ul * 4096; bf16_t* GQ = (bf16_t*)(((unsigned char*)(F.ws + WS_XB)) + SC_GQ) + (size_t)ul * 4096;
    bf16_t* GKT = (bf16_t*)(((unsigned char*)(F.ws + WS_XB)) + SC_GKT) + (size_t)ul * 4096; bf16_t* GU = (bf16_t*)(((unsigned char*)(F.ws + WS_XB)) + SC_GU) + (size_t)ul * 4096; float* GV = (float*)(((unsigned char*)(F.ws + WS_XB)) + SC_GVEC) + (size_t)ul * 256;
#pragma unroll 4
    for (int i = 0; i < 24; ++i) { const int idx = tid + 512 * i, tsr = idx >> 12, rem = idx & 4095, t = rem >> 6, d = rem & 63;
        const int cwi = tsr * 384 + h * 64 + d, col = C_GQ + cwi, tok = n * 64 + t; float s = 0.f;
#pragma unroll
        for (int kk = 0; kk < 4; ++kk) { const int tt = tok - 3 + kk; if (tt >= 0) s += cw[kk * 1152 + cwi] * bf2f(hin[(size_t)tt * DINP + col]); }
        F.ldsf[tsr * 64 * LS + t * LS + d] = siluf_(s); }
    __syncthreads();
    { const int r = tid >> 2, part = tid & 3; float* p = F.ldsf + (r >> 6) * 64 * LS + (r & 63) * LS + part * 16; float ss = 0.f;
#pragma unroll
      for (int i = 0; i < 16; ++i) ss += p[i] * p[i];
      ss += __shfl_xor(ss, 1); ss += __shfl_xor(ss, 2);
      const float sc = __builtin_amdgcn_rsqf(ss + 1e-6f) * (r < 64 ? 0.125f : 1.0f);
#pragma unroll
      for (int i = 0; i < 16; ++i) p[i] *= sc; }
    if (tid < 64) { const size_t ro = (size_t)(n * 64 + tid) * DINP; const float ag = bf2f(hin[ro + C_GA + h]), bg = bf2f(hin[ro + C_GB + h]);
        const float xs = ag + ((const float*)(const GAS float*)F.ap->in[19])[l * 6 + h]; const float sp = xs > 20.f ? xs : log1p_pos(__expf(xs));
        vec[tid] = -__expf(((const float*)(const GAS float*)F.ap->in[18])[l * 6 + h]) * sp; vec[64 + tid] = sigmoidf_(bg); }
    __syncthreads();
    if (tid < 64) { float v = vec[tid];
#pragma unroll
        for (int o = 1; o < 64; o <<= 1) { const float u = __shfl_up(v, o); if (tid >= o) v += u; }
        const float gl = __shfl(v, 63); const float eg = __expf(v), et = __expf(gl - v);
        vec[128 + tid] = v; vec[192 + tid] = eg; vec[256 + tid] = et; GV[tid] = eg; GV[64 + tid] = et; }
    __syncthreads();
    { const int j = tid & 63, iw = tid >> 6; float aK[8], aQ[8]; dot_rows(Kx, Kx, iw, j, aK); dot_rows(Q, Kx, iw, j, aQ);
      const float gcj = vec[128 + j];
#pragma unroll
      for (int ii = 0; ii < 8; ++ii) { const int i = iw + 8 * ii; const float dec = (j <= i) ? __expf(fminf(vec[128 + i] - gcj, 0.f)) : 0.f;
          A[i * LS + j] = (j < i) ? vec[64 + i] * aK[ii] * dec : 0.f;
          GQK[frag_off(i, j)] = (bf16_t)f2bf(aQ[ii] * dec); } }
#pragma unroll 4
    for (int i = 0; i < 16; ++i) { const int idx = tid + 512 * i, which = idx >> 12, rem = idx & 4095, cc = rem >> 6, r = rem & 63;
        if (which == 0) GQ[frag_off(cc, r)] = (bf16_t)f2bf(Q[cc * LS + r] * vec[192 + cc]);
        else GKT[frag_off(r, cc)] = (bf16_t)f2bf(Kx[cc * LS + r] * vec[256 + cc]); }
    __syncthreads();
    { constexpr int XL = 132; float* XS = vec + 320;
#pragma unroll 4
      for (int i = 0; i < 16; ++i) { const int idx = tid + 512 * i, r = idx >> 7, c = idx & 127; const float bi = vec[64 + r];
          XS[r * XL + c] = (c < 64) ? V[r * LS + c] * bi : Kx[r * LS + (c - 64)] * bi * vec[192 + r]; }
      __syncthreads();
#pragma unroll 1
      for (int ib = 0; ib < 4; ++ib) {
          if (ib > 0) { const int c = tid & 127, r0 = 16 * ib + (tid >> 7) * 4; float s0 = 0.f, s1 = 0.f, s2 = 0.f, s3 = 0.f;
#pragma unroll 2
              for (int j = 0; j < 16 * ib; j += 4) { const float x0 = XS[j * XL + c], x1 = XS[(j + 1) * XL + c], x2 = XS[(j + 2) * XL + c], x3 = XS[(j + 3) * XL + c];
                  const f32x4 a0 = *(const f32x4*)(A + r0 * LS + j), a1 = *(const f32x4*)(A + (r0 + 1) * LS + j), a2 = *(const f32x4*)(A + (r0 + 2) * LS + j), a3 = *(const f32x4*)(A + (r0 + 3) * LS + j);
                  s0 += (a0.x * x0 + a0.y * x1) + (a0.z * x2 + a0.w * x3); s1 += (a1.x * x0 + a1.y * x1) + (a1.z * x2 + a1.w * x3);
                  s2 += (a2.x * x0 + a2.y * x1) + (a2.z * x2 + a2.w * x3); s3 += (a3.x * x0 + a3.y * x1) + (a3.z * x2 + a3.w * x3); }
              XS[r0 * XL + c] -= s0; XS[(r0 + 1) * XL + c] -= s1; XS[(r0 + 2) * XL + c] -= s2; XS[(r0 + 3) * XL + c] -= s3;
              __syncthreads(); }
          if (tid < 128) { const int c = tid; float x[16];
              int z0; asm volatile("v_mov_b32 %0, 0" : "=v"(z0));
              const float* Az = A + z0 + (16 * ib) * LS + 16 * ib;
#pragma unroll
              for (int r = 0; r < 16; ++r) x[r] = XS[(16 * ib + r) * XL + c];
#pragma unroll
              for (int r = 1; r < 16; ++r) { float sacc = x[r];
#pragma unroll
                  for (int j4 = 0; j4 <= ((r - 1) >> 2); ++j4) { const f32x4 a = *(const f32x4*)(Az + r * LS + 4 * j4);
                      sacc -= a.x * x[4 * j4]; if (4 * j4 + 1 < r) sacc -= a.y * x[4 * j4 + 1]; if (4 * j4 + 2 < r) sacc -= a.z * x[4 * j4 + 2]; if (4 * j4 + 3 < r) sacc -= a.w * x[4 * j4 + 3]; }
                  x[r] = sacc; }
#pragma unroll
              for (int r = 0; r < 16; ++r) XS[(16 * ib + r) * XL + c] = x[r]; }
          __syncthreads();
      }
#pragma unroll 4
      for (int i = 0; i < 16; ++i) { const int idx = tid + 512 * i, r = idx >> 7, c = idx & 127; const bf16_t v = (bf16_t)f2bf(XS[r * XL + c]);
          if (c < 64) GU[cfrag_off(r, c)] = v; else GW[frag_off(r, c - 64)] = v; }
    }
    __syncthreads();
}

__device__ __forceinline__ void ret_par_unit(Frame& F, int l, int b, int n, int h, int ul) {
    float* Q = F.ldsf; float* Kx = Q + 64 * LS; float* V = Kx + 64 * LS; float* gp = V + 64 * LS;
    const int tid = F.tid;
    const bf16_t* hin = ((bf16_t*)(F.ws + WS_BIG)) + (size_t)b * SEQL * DINP;
    const int* pos = (const int*)(const GAS int*)F.ap->in[2] + (size_t)b * SEQL + n * 64;
    bf16_t* GSC = (bf16_t*)(((unsigned char*)(F.ws + WS_XB)) + SC_RSC) + (size_t)ul * 4096; bf16_t* GQX = (bf16_t*)(((unsigned char*)(F.ws + WS_XB)) + SC_RQX) + (size_t)ul * 4096;
    bf16_t* GKT = (bf16_t*)(((unsigned char*)(F.ws + WS_XB)) + SC_RKT) + (size_t)ul * 4096; bf16_t* GVT = (bf16_t*)(((unsigned char*)(F.ws + WS_XB)) + SC_RVT) + (size_t)ul * 4096;
    const float lg = (h == 0) ? -0.031748698314580f : (h == 1) ? -0.015748356968139f : (h == 2) ? -0.007843177461025f : -0.003913899321136f;
    if (tid < 65) gp[tid] = __expf((float)tid * lg);
#pragma unroll 2
    for (int it = 0; it < 8; ++it) { const int idx = tid + 512 * it, tsr = idx >> 11, rem = idx & 2047, t = rem >> 5, i = rem & 31;
        const size_t ro = (size_t)(n * 64 + t) * DINP + (tsr ? C_RK : C_RQ) + h * 64;
        const float x1 = bf2f(hin[ro + i]), x2 = bf2f(hin[ro + i + 32]);
        const double rev = (double)pos[t] * INVF_REV[i]; const float fr = (float)(rev - __builtin_rint(rev));
        const float cs = __builtin_amdgcn_cosf(fr), sn = __builtin_amdgcn_sinf(fr); const float sc = tsr ? 1.0f : 0.125f;
        float* dst = F.ldsf + tsr * 64 * LS + t * LS; dst[i] = (x1 * cs - x2 * sn) * sc; dst[i + 32] = (x2 * cs + x1 * sn) * sc; }
#pragma unroll 2
    for (int it = 0; it < 8; ++it) { const int idx = tid + 512 * it, t = idx >> 6, d = idx & 63; V[t * LS + d] = bf2f(hin[(size_t)(n * 64 + t) * DINP + C_RV + h * 64 + d]); }
    __syncthreads();
    { const int j = tid & 63, iw = tid >> 6; float aQ[8]; dot_rows(Q, Kx, iw, j, aQ);
#pragma unroll
      for (int ii = 0; ii < 8; ++ii) { const int i = iw + 8 * ii; const int dd = i > j ? i - j : j - i; GSC[frag_off(i, j)] = (bf16_t)f2bf(aQ[ii] * gp[dd]); } }
#pragma unroll 4
    for (int i = 0; i < 24; ++i) { const int idx = tid + 512 * i, which = idx >> 12, rem = idx & 4095, cc = rem >> 6, r = rem & 63;
        if (which == 0) GQX[frag_off(cc, r)] = (bf16_t)f2bf(Q[cc * LS + r] * gp[cc + 1]);
        else if (which == 1) GKT[frag_off(r, cc)] = (bf16_t)f2bf(Kx[cc * LS + r] * gp[63 - cc]);
        else GVT[bfrag_off(cc, r)] = (bf16_t)f2bf(V[cc * LS + r]); }
    __syncthreads();
}

__device__ __forceinline__ void lru_par_unit(Frame& F, int l, int b, int bl, int n, int g) {
    float* XC = F.ldsf; float* WA = XC + 64 * LS; float* WX = WA + 4096; float* AA = WX + 4096; float* BB = AA + 4096;
    const int tid = F.tid;
    const bf16_t* hin = ((bf16_t*)(F.ws + WS_BIG)) + (size_t)b * SEQL * DINP;
    const float* wa = ((const float*)(const GAS float*)F.ap->in[12]) + (size_t)(l * 6 + g) * 4096; const float* wx = ((const float*)(const GAS float*)F.ap->in[14]) + (size_t)(l * 6 + g) * 4096;
    const float* cw = ((const float*)(const GAS float*)F.ap->in[10]) + (size_t)l * 4 * 384; const float* cb = ((const float*)(const GAS float*)F.ap->in[11]) + (size_t)l * 384;
#pragma unroll 4
    for (int i = 0; i < 8; ++i) { const int idx = tid + 512 * i; WA[idx] = wa[idx]; WX[idx] = wx[idx]; }
#pragma unroll 2
    for (int i = 0; i < 8; ++i) { const int idx = tid + 512 * i, t = idx >> 6, c = idx & 63, ch = g * 64 + c, tok = n * 64 + t; float s = cb[ch];
#pragma unroll
        for (int kk = 0; kk < 4; ++kk) { const int tt = tok - 3 + kk; if (tt >= 0) s += cw[kk * 384 + ch] * bf2f(hin[(size_t)tt * DINP + C_LX + ch]); }
        XC[t * LS + c] = s; }
    __syncthreads();
    { const int j = tid & 63, tw = tid >> 6, ch = g * 64 + j; float aA[8], aX[8];
#pragma unroll
      for (int ii = 0; ii < 8; ++ii) { aA[ii] = 0.f; aX[ii] = 0.f; }
#pragma unroll 2
      for (int i4 = 0; i4 < 16; ++i4) { float w_a[4], w_x[4];
#pragma unroll
          for (int k = 0; k < 4; ++k) { w_a[k] = WA[(4 * i4 + k) * 64 + j]; w_x[k] = WX[(4 * i4 + k) * 64 + j]; }
#pragma unroll
          for (int ii = 0; ii < 8; ++ii) { const f32x4 x = *(const f32x4*)(XC + (tw + 8 * ii) * LS + 4 * i4);
              aA[ii] += (x.x * w_a[0] + x.y * w_a[1]) + (x.z * w_a[2] + x.w * w_a[3]); aX[ii] += (x.x * w_x[0] + x.y * w_x[1]) + (x.z * w_x[2] + x.w * w_x[3]); } }
      const float ba = ((const float*)(const GAS float*)F.ap->in[13])[l * 384 + ch], bx = ((const float*)(const GAS float*)F.ap->in[15])[l * 384 + ch], lam = ((const float*)(const GAS float*)F.ap->in[16])[l * 384 + ch];
      const float ls = (-lam > 20.f) ? lam : -log1p_pos(__expf(-lam));
#pragma unroll
      for (int ii = 0; ii < 8; ++ii) { const int t = tw + 8 * ii; const float r = sigmoidf_(aA[ii] + ba), ig = sigmoidf_(aX[ii] + bx);
          const float la = 8.0f * r * ls; const float a = __expf(la); const float bc = __builtin_amdgcn_sqrtf(fmaxf(one_minus_exp(2.0f * la), 0.f)) * (ig * XC[t * LS + j]);
          AA[t * 64 + j] = a; BB[t * 64 + j] = bc; } }
    __syncthreads();
    if (tid < 64) { float hcur = 0.f, ac = 1.f;
#pragma unroll 8
        for (int t = 0; t < 64; ++t) { const float a = AA[t * 64 + tid], bb = BB[t * 64 + tid]; hcur = a * hcur + bb; ac *= a; BB[t * 64 + tid] = hcur; AA[t * 64 + tid] = ac; }
        const size_t so = (size_t)(bl * 128 + n) * 384 + g * 64 + tid; ((float*)(((unsigned char*)(F.ws + WS_XB)) + SC_LSH))[so] = hcur; ((float*)(((unsigned char*)(F.ws + WS_XB)) + SC_LSA))[so] = ac; }
    __syncthreads();
    bf16_t* P2 = (bf16_t*)(((unsigned char*)(F.ws + WS_XB)) + SC_LP2);
#pragma unroll 2
    for (int i = 0; i < 8; ++i) { const int idx = tid + 512 * i, t = idx >> 6, c = idx & 63, ch = g * 64 + c, tok = n * 64 + t;
        const float ge = gelu_tanh(bf2f(hin[(size_t)tok * DINP + C_LG + ch]));
        ((bf16_t*)(F.ws + WS_O))[((size_t)b * SEQL + tok) * DM + O_L + ch] = (bf16_t)f2bf(BB[t * 64 + c] * ge);
        P2[((size_t)bl * SEQL + tok) * 384 + ch] = (bf16_t)f2bf(AA[t * 64 + c] * ge); }
    __syncthreads();
}

#ifndef PMASK
#define PMASK 7
#endif
#define PSEL(b) ((PMASK & (b)) != 0)
__device__ __forceinline__ void p_mix_par(Frame& F, int l, int half) {
    for (int u = F.bid; u < 8192; u += F.G) {
        if (u < 3072) { const int h = u % 6, n = (u / 6) & 127, bl = u / 768; if (PSEL(1)) gdn_par_unit(F, l, half * 4 + bl, n, h, u); }
        else if (u < 5120) { const int v = u - 3072; const int h = v & 3, n = (v >> 2) & 127, bl = v >> 9; if (PSEL(2)) ret_par_unit(F, l, half * 4 + bl, n, h, v); }
        else { const int v = u - 5120; const int g = v % 6, n = (v / 6) & 127, bl = v / 768; if (PSEL(4)) lru_par_unit(F, l, half * 4 + bl, bl, n, g); }
    }
}

#define MFMA16(a, b, c) __builtin_amdgcn_mfma_f32_16x16x32_bf16((a), (b), (c), 0, 0, 0)
__device__ __forceinline__ void gdn_seq_chain(Frame& F, int l, int b, int bl, int h) {
    const int w = F.wave, lane = F.lane, q = lane >> 4, l15 = lane & 15; const bool act = w < 4;
    float* red = F.ldsf;
    const bf16_t* hin = ((bf16_t*)(F.ws + WS_BIG)) + (size_t)b * SEQL * DINP;
    const int e = (w & 3) * 16 + l15;
    const float gn = ((const float*)(const GAS float*)F.ap->in[20])[l * 64 + e];
    f32x4 S[4];
#pragma unroll
    for (int i = 0; i < 4; ++i) S[i] = (f32x4){0.f, 0.f, 0.f, 0.f};
    bf16x8 Wf[8], Qf[8], QKf[8], KTf[8]; bf16x4 Uf[4];
    const size_t u0 = (size_t)(bl * 128) * 6 + h;
    const bf16x8* pW = (const bf16x8*)(((unsigned char*)(F.ws + WS_XB)) + SC_GW) + u0 * 512 + lane; const bf16x8* pQ = (const bf16x8*)(((unsigned char*)(F.ws + WS_XB)) + SC_GQ) + u0 * 512 + lane;
    const bf16x8* pQK = (const bf16x8*)(((unsigned char*)(F.ws + WS_XB)) + SC_GQK) + u0 * 512 + lane; const bf16x8* pKT = (const bf16x8*)(((unsigned char*)(F.ws + WS_XB)) + SC_GKT) + u0 * 512 + lane;
    const bf16x4* pU = (const bf16x4*)(((unsigned char*)(F.ws + WS_XB)) + SC_GU) + u0 * 1024 + (w & 3) * 64 + lane; const float* pV = (const float*)(((unsigned char*)(F.ws + WS_XB)) + SC_GVEC) + u0 * 256;
    if (act) {
#pragma unroll
        for (int f = 0; f < 8; ++f) { Wf[f] = pW[f * 64]; Qf[f] = pQ[f * 64]; QKf[f] = pQK[f * 64]; KTf[f] = pKT[f * 64]; }
#pragma unroll
        for (int mt = 0; mt < 4; ++mt) Uf[mt] = pU[mt * 256];
    }
    for (int n = 0; n < NCH; ++n) {
        f32x4 Oa[4]; float zg[4][4];
        if (act) {
            const float* gv = pV + (size_t)n * 6 * 256;
            const float egl = gv[63];
#pragma unroll
            for (int mt = 0; mt < 4; ++mt)
#pragma unroll
                for (int j = 0; j < 4; ++j) zg[mt][j] = bf2f(hin[(size_t)(n * 64 + 16 * mt + 4 * q + j) * DINP + C_GZ + h * 64 + e]);
            bf16x8 Sb[2]; Sb[0] = pack8(S[0], S[1]); Sb[1] = pack8(S[2], S[3]);
            f32x4 P[4];
#pragma unroll
            for (int mt = 0; mt < 4; ++mt) { const f32x4 z = {0.f, 0.f, 0.f, 0.f}; P[mt] = MFMA16(Wf[mt * 2], Sb[0], z); P[mt] = MFMA16(Wf[mt * 2 + 1], Sb[1], P[mt]);
                Oa[mt] = MFMA16(Qf[mt * 2], Sb[0], z); Oa[mt] = MFMA16(Qf[mt * 2 + 1], Sb[1], Oa[mt]); }
            const size_t nx = (size_t)(n + 1 < NCH ? n + 1 : n) * 6;
#pragma unroll
            for (int f = 0; f < 8; ++f) { Wf[f] = pW[nx * 512 + f * 64]; Qf[f] = pQ[nx * 512 + f * 64]; }
            f32x4 vn[4];
#pragma unroll
            for (int mt = 0; mt < 4; ++mt) vn[mt] = unpack4(Uf[mt]) - P[mt];
            bf16x8 vnb[2];
            vnb[0] = pack8(vn[0], vn[1]); vnb[1] = pack8(vn[2], vn[3]);
#pragma unroll
            for (int mt = 0; mt < 4; ++mt) { Oa[mt] = MFMA16(QKf[mt * 2], vnb[0], Oa[mt]); Oa[mt] = MFMA16(QKf[mt * 2 + 1], vnb[1], Oa[mt]);
                S[mt] = S[mt] * egl; S[mt] = MFMA16(KTf[mt * 2], vnb[0], S[mt]); S[mt] = MFMA16(KTf[mt * 2 + 1], vnb[1], S[mt]); }
#pragma unroll
            for (int f = 0; f < 8; ++f) { QKf[f] = pQK[nx * 512 + f * 64]; KTf[f] = pKT[nx * 512 + f * 64]; }
#pragma unroll
            for (int mt = 0; mt < 4; ++mt) Uf[mt] = pU[nx * 1024 + mt * 256];
#pragma unroll
            for (int mt = 0; mt < 4; ++mt)
#pragma unroll
                for (int j = 0; j < 4; ++j) { float ss = Oa[mt][j] * Oa[mt][j]; ss += __shfl_xor(ss, 1); ss += __shfl_xor(ss, 2); ss += __shfl_xor(ss, 4); ss += __shfl_xor(ss, 8);
                    if (l15 == 0) red[(n & 1) * 256 + w * 64 + 16 * mt + 4 * q + j] = ss; }
        }
        __syncthreads();
        if (act) {
            const float* rd = red + (n & 1) * 256;
#pragma unroll
            for (int mt = 0; mt < 4; ++mt)
#pragma unroll
                for (int j = 0; j < 4; ++j) { const int c = 16 * mt + 4 * q + j; const float tot = (rd[c] + rd[64 + c]) + (rd[128 + c] + rd[192 + c]);
                    const float rs = __builtin_amdgcn_rsqf(tot * (1.0f / 64.0f) + 1e-6f);
                    ((bf16_t*)(F.ws + WS_O))[((size_t)b * SEQL + n * 64 + c) * DM + O_G + h * 64 + e] = (bf16_t)f2bf(Oa[mt][j] * rs * gn * siluf_(zg[mt][j])); }
        }
    }
}
__device__ __forceinline__ void ret_seq_chain(Frame& F, int l, int b, int bl, int h) {
    const int w = F.wave, lane = F.lane, q = lane >> 4, l15 = lane & 15; const bool act = w < 4;
    float* red = F.ldsf;
    const bf16_t* hin = ((bf16_t*)(F.ws + WS_BIG)) + (size_t)b * SEQL * DINP;
    const int e = (w & 3) * 16 + l15;
    const float rg = ((const float*)(const GAS float*)F.ap->in[9])[l * 256 + h * 64 + e];
    const float cd = __expf(64.0f * ((h == 0) ? -0.031748698314580f : (h == 1) ? -0.015748356968139f : (h == 2) ? -0.007843177461025f : -0.003913899321136f));
    f32x4 S[4];
#pragma unroll
    for (int i = 0; i < 4; ++i) S[i] = (f32x4){0.f, 0.f, 0.f, 0.f};
    bf16x8 SCf[8], QXf[8], KTf[8], Vb[2];
    const size_t u0 = (size_t)(bl * 128) * 4 + h;
    const bf16x8* pSC = (const bf16x8*)(((unsigned char*)(F.ws + WS_XB)) + SC_RSC) + u0 * 512 + lane; const bf16x8* pQX = (const bf16x8*)(((unsigned char*)(F.ws + WS_XB)) + SC_RQX) + u0 * 512 + lane;
    const bf16x8* pKT = (const bf16x8*)(((unsigned char*)(F.ws + WS_XB)) + SC_RKT) + u0 * 512 + lane; const bf16x8* pVT = (const bf16x8*)(((unsigned char*)(F.ws + WS_XB)) + SC_RVT) + u0 * 512 + (w & 3) * 64 + lane;
    if (act) {
#pragma unroll
        for (int f = 0; f < 8; ++f) { SCf[f] = pSC[f * 64]; QXf[f] = pQX[f * 64]; KTf[f] = pKT[f * 64]; }
        Vb[0] = pVT[0]; Vb[1] = pVT[256];
    }
    for (int n = 0; n < NCH; ++n) {
        f32x4 Oa[4]; float zg[4][4];
        if (act) {
#pragma unroll
            for (int mt = 0; mt < 4; ++mt)
#pragma unroll
                for (int j = 0; j < 4; ++j) zg[mt][j] = bf2f(hin[(size_t)(n * 64 + 16 * mt + 4 * q + j) * DINP + C_RG + h * 64 + e]);
            bf16x8 Sb[2]; Sb[0] = pack8(S[0], S[1]); Sb[1] = pack8(S[2], S[3]);
#pragma unroll
            for (int mt = 0; mt < 4; ++mt) { const f32x4 z = {0.f, 0.f, 0.f, 0.f}; Oa[mt] = MFMA16(QXf[mt * 2], Sb[0], z); Oa[mt] = MFMA16(QXf[mt * 2 + 1], Sb[1], Oa[mt]);
                Oa[mt] = MFMA16(SCf[mt * 2], Vb[0], Oa[mt]); Oa[mt] = MFMA16(SCf[mt * 2 + 1], Vb[1], Oa[mt]);
                S[mt] = S[mt] * cd; S[mt] = MFMA16(KTf[mt * 2], Vb[0], S[mt]); S[mt] = MFMA16(KTf[mt * 2 + 1], Vb[1], S[mt]); }
            const size_t nx = (size_t)(n + 1 < NCH ? n + 1 : n) * 4;
#pragma unroll
            for (int f = 0; f < 8; ++f) { SCf[f] = pSC[nx * 512 + f * 64]; QXf[f] = pQX[nx * 512 + f * 64]; KTf[f] = pKT[nx * 512 + f * 64]; }
            Vb[0] = pVT[nx * 512]; Vb[1] = pVT[nx * 512 + 256];
#pragma unroll
            for (int mt = 0; mt < 4; ++mt)
#pragma unroll
                for (int j = 0; j < 4; ++j) { float s1 = Oa[mt][j], s2 = s1 * s1;
                    s1 += __shfl_xor(s1, 1); s2 += __shfl_xor(s2, 1); s1 += __shfl_xor(s1, 2); s2 += __shfl_xor(s2, 2); s1 += __shfl_xor(s1, 4); s2 += __shfl_xor(s2, 4); s1 += __shfl_xor(s1, 8); s2 += __shfl_xor(s2, 8);
                    if (l15 == 0) { red[(n & 1) * 512 + w * 64 + 16 * mt + 4 * q + j] = s1; red[(n & 1) * 512 + 256 + w * 64 + 16 * mt + 4 * q + j] = s2; } }
        }
        __syncthreads();
        if (act) {
            const float* rd = red + (n & 1) * 512;
#pragma unroll
            for (int mt = 0; mt < 4; ++mt)
#pragma unroll
                for (int j = 0; j < 4; ++j) { const int c = 16 * mt + 4 * q + j; const float t1 = (rd[c] + rd[64 + c]) + (rd[128 + c] + rd[192 + c]), t2 = (rd[256 + c] + rd[320 + c]) + (rd[384 + c] + rd[448 + c]);
                    const float mu = t1 * (1.0f / 64.0f); const float var = fmaxf(t2 * (1.0f / 64.0f) - mu * mu, 0.f); const float rs = __builtin_amdgcn_rsqf(var + 1e-5f);
                    ((bf16_t*)(F.ws + WS_O))[((size_t)b * SEQL + n * 64 + c) * DM + O_R + h * 64 + e] = (bf16_t)f2bf((Oa[mt][j] - mu) * rs * rg * siluf_(zg[mt][j])); }
        }
    }
}
__device__ __forceinline__ void lru_seq_chain(Frame& F, int b, int bl, int g) {
    const int w = F.wave, c = F.lane, ch = g * 64 + c;
    const float* SH = (const float*)(((unsigned char*)(F.ws + WS_XB)) + SC_LSH); const float* SA = (const float*)(((unsigned char*)(F.ws + WS_XB)) + SC_LSA); const bf16_t* P2 = (const bf16_t*)(((unsigned char*)(F.ws + WS_XB)) + SC_LP2);
    float carry = 0.f;
    for (int n = 0; n < NCH; ++n) {
        const size_t so = (size_t)(bl * 128 + n) * 384 + ch; const float sh = SH[so], sa = SA[so];
#pragma unroll
        for (int tt = 0; tt < 8; ++tt) { const int tok = n * 64 + w * 8 + tt; bf16_t* op = ((bf16_t*)(F.ws + WS_O)) + ((size_t)b * SEQL + tok) * DM + O_L + ch;
            const float p1 = bf2f(*op), p2 = bf2f(P2[((size_t)bl * SEQL + tok) * 384 + ch]); *op = (bf16_t)f2bf(p1 + p2 * carry); }
        carry = sh + sa * carry;
    }
}
__device__ __forceinline__ void p_mix_seq(Frame& F, int l, int half) {
    const int ci = F.bid;
    if (ci < 24) { const int bl = ci / 6, h = ci % 6; gdn_seq_chain(F, l, half * 4 + bl, bl, h); }
    else if (ci < 40) { const int v = ci - 24; const int bl = v >> 2, h = v & 3; ret_seq_chain(F, l, half * 4 + bl, bl, h); }
    else if (ci < 64) { const int v = ci - 40; const int bl = v / 6, g = v % 6; lru_seq_chain(F, half * 4 + bl, bl, g); }
}

#ifndef GMASK
#define GMASK 63
#endif
#define GSEL(b) ((GMASK & (b)) != 0)
__global__ void __launch_bounds__(512, 2) fwd(Args args) {
    extern __shared__ __attribute__((aligned(16))) unsigned char lds[];
    const int lo = args.ph_lo, hi = args.ph_hi;
    for (int ph = lo; ph < hi; ++ph) {
        if (ph > lo) {
            __builtin_amdgcn_fence(__ATOMIC_RELEASE, "agent"); asm volatile("s_waitcnt vmcnt(0) lgkmcnt(0)" ::: "memory");
            cg::this_grid().sync();
            __builtin_amdgcn_fence(__ATOMIC_ACQUIRE, "agent"); asm volatile("s_waitcnt vmcnt(0) lgkmcnt(0)" ::: "memory");
        }
        Frame F;
        { int t_ = threadIdx.x; asm volatile("" : "+v"(t_));
          const CAS Args* ap_ = (const CAS Args*)__builtin_amdgcn_kernarg_segment_ptr(); asm volatile("" : "+s"(ap_)); F.ap = ap_; GAS unsigned char* w_ = (GAS unsigned char*)ap_->ws;
          F.lds = (LAS unsigned char*)lds; F.ldsf = (float*)lds; F.tid = t_; F.lane = t_ & 63; F.wave = __builtin_amdgcn_readfirstlane(t_ >> 6); int g_ = gridDim.x, b_ = blockIdx.x; asm volatile("" : "+s"(g_), "+s"(b_)); F.G = g_; F.bid = b_; F.ws = w_; }
        if (ph == 0) { p_prologue(F); continue; }
        const int l = (ph - 1) / 13, s = (ph - 1) % 13;
        unsigned char* wt = (unsigned char*)(F.ws + WS_WT + (size_t)l * WT_LAYER);
        if (GSEL(1) && (s == 0 || s == 10)) {
            if (GSEL(32)) { pg8::Gemm g{((bf16_t*)((unsigned char*)(F.ws + WS_XB))), (const bf16_t*)(wt + (s == 0 ? WT_GU1 : WT_GU2))}; pg8::StaticOrder S; S.init(M, 2 * DFF, F.G, F.bid);
              pg8::EpiGated<0> E{((bf16_t*)(F.ws + WS_BIG)), DFF}; pg8::gemm_phase<XBLD, DM, DM>(F.lds, F.tid, g, S, E); }
            if (GSEL(2) && s == 10) { pg8::Gemm g{((bf16_t*)((unsigned char*)(F.ws + WS_XB))), (const bf16_t*)(wt + WT_PLE)}; pg8::StaticOrder S; S.init(M, 2048, F.G, F.bid);
              pg8::EpiGated<1> E{((bf16_t*)(F.ws + WS_O)), DM}; pg8::gemm_phase<XBLD, XBLD, XBLD>(F.lds, F.tid, g, S, E); }
        } else if (GSEL(4) && (s == 1 || s == 11)) {
            pg8::Gemm g{((bf16_t*)(F.ws + WS_BIG)), (const bf16_t*)(wt + (s == 1 ? WT_D1 : WT_D2))}; pg8::StaticOrder S; S.init(M, DM, F.G, F.bid);
            pg8::EpiResid E{(ph == 2) ? ((const float*)(const GAS float*)F.ap->in[0]) : ((float*)(GAS float*)F.ap->out), ((float*)(GAS float*)F.ap->out), (s == 11) ? ((bf16_t*)(F.ws + WS_O)) : (const bf16_t*)nullptr, 0.5f}; pg8::gemm_phase<DFF, DFF, DFF>(F.lds, F.tid, g, S, E);
        } else if (s == 2) { p_layernorm(F, ((const float*)(const GAS float*)F.ap->in[3]) + l * DM, ((const float*)(const GAS float*)F.ap->in[4]) + l * DM, nullptr);
        } else if (GSEL(8) && s == 3) {
            pg8::Gemm g{((bf16_t*)((unsigned char*)(F.ws + WS_XB))), (const bf16_t*)(wt + WT_IN)}; pg8::StaticOrder S; S.init(M, DINP, F.G, F.bid);
            pg8::EpiBf16 E{((bf16_t*)(F.ws + WS_BIG)), DINP}; pg8::gemm_phase<XBLD, DM, DM>(F.lds, F.tid, g, S, E);
#ifndef NO_PAR
        } else if (s == 4 || s == 6) { p_mix_par(F, l, (s - 4) >> 1);
#endif
#ifndef NO_SEQ
        } else if (s == 5 || s == 7) { p_mix_seq(F, l, (s - 5) >> 1);
#endif
        } else if (GSEL(16) && s == 8) {
            pg8::Gemm g{((bf16_t*)(F.ws + WS_O)), (const bf16_t*)(wt + WT_OUT)}; pg8::StaticOrder S; S.init(M, DM, F.G, F.bid);
            pg8::EpiResid E{((float*)(GAS float*)F.ap->out), ((float*)(GAS float*)F.ap->out), (const bf16_t*)nullptr, 1.0f}; pg8::gemm_phase<DM, DM, DM>(F.lds, F.tid, g, S, E);
        } else if (s == 9) { p_layernorm(F, ((const float*)(const GAS float*)F.ap->in[22]) + l * DM, ((const float*)(const GAS float*)F.ap->in[23]) + l * DM, ((const float*)(const GAS float*)F.ap->in[1]) + (size_t)l * M * 256);
        } else if (s == 12) { p_layernorm(F, ((const float*)(const GAS float*)F.ap->in[29]) + l * DM, ((const float*)(const GAS float*)F.ap->in[30]) + l * DM, nullptr); }
    }
}

extern "C" void kernel_launch(void* const* d_in, const int* in_sizes, int n_in, void* d_out, int out_size, void* d_ws, size_t ws_size, hipStream_t stream) {
    static int grid = 0;
    if (grid == 0) {
        if (n_in != 31 || out_size != M * DM || ws_size < WS_END) { fprintf(stderr, "kernel_launch: unexpected shapes (n_in %d out %d ws %zu)\n", n_in, out_size, ws_size); grid = -1; return; }
        int dev = 0, cus = 0;
        hipGetDevice(&dev); hipDeviceGetAttribute(&cus, hipDeviceAttributeMultiprocessorCount, dev);
        if (hipFuncSetAttribute((const void*)fwd, hipFuncAttributeMaxDynamicSharedMemorySize, LDS_BYTES) != hipSuccess) { fprintf(stderr, "hipFuncSetAttribute failed\n"); grid = -1; return; }
        int per_cu = 0; hipOccupancyMaxActiveBlocksPerMultiprocessor(&per_cu, (const void*)fwd, 512, LDS_BYTES); (void)hipGetLastError();
        grid = cus > 0 ? cus : 256;
        if (grid < 64) grid = -1;
    }
    if (grid < 0) return;
    Args a{};
    for (int i = 0; i < 31; ++i) a.in[i] = d_in[i];
    a.out = (float*)d_out; a.ws = (unsigned char*)d_ws;
#if ONE_LAUNCH
    a.ph_lo = 0; a.ph_hi = NPH;
    void* kargs[] = {&a};
    hipError_t e = hipLaunchCooperativeKernel((const void*)fwd, dim3(grid), dim3(512), kargs, LDS_BYTES, stream);
    if (e != hipSuccess) fprintf(stderr, "cooperative launch failed: %s\n", hipGetErrorString(e));
#else
    for (int ph = 0; ph < NPH; ++ph) { a.ph_lo = ph; a.ph_hi = ph + 1; hipLaunchKernelGGL(fwd, dim3(grid), dim3(512), LDS_BYTES, stream, a); }
#endif
}
```

```cpp
#include <hip/hip_runtime.h>
#include <hip/hip_cooperative_groups.h>
#include <cstdio>
#include <cstdint>
namespace cg = cooperative_groups;

#ifndef ONE_LAUNCH
#define ONE_LAUNCH 1
#endif

#define LAS __attribute__((address_space(3)))
#define GAS __attribute__((address_space(1)))
#define CAS __attribute__((address_space(4)))
typedef unsigned short bf16_t;
typedef short bf16x8 __attribute__((ext_vector_type(8)));
typedef short bf16x4 __attribute__((ext_vector_type(4)));
typedef float f32x4 __attribute__((ext_vector_type(4)));
typedef float f32x2 __attribute__((ext_vector_type(2)));
typedef unsigned u32x4 __attribute__((ext_vector_type(4)));
typedef unsigned u32x2 __attribute__((ext_vector_type(2)));

constexpr int M = 65536, DM = 1024, DFF = 2816, DIN = 3340, DINP = 3584, SEQL = 8192, NCH = 128;
constexpr int XBLD = 1280;
constexpr float ALPHA = 1.41421356237309515f;
constexpr float LN_EPS = 1e-5f;
constexpr int C_RQ = 0, C_RK = 256, C_RV = 512, C_RG = 768, C_LX = 1024, C_LG = 1408, C_GQ = 1792, C_GK = 2176, C_GV = 2560, C_GZ = 2944, C_GA = 3328, C_GB = 3334;
constexpr int O_R = 0, O_L = 256, O_G = 640;

constexpr size_t MiB = 1u << 20;
constexpr size_t WS_WT = 1 * MiB;
constexpr size_t WT_GU1 = 0, WT_D1 = WT_GU1 + (size_t)5632 * 1024 * 2, WT_IN = WT_D1 + (size_t)1024 * 2816 * 2, WT_OUT = WT_IN + (size_t)3584 * 1024 * 2,
                 WT_GU2 = WT_OUT + (size_t)1024 * 1024 * 2, WT_D2 = WT_GU2 + (size_t)5632 * 1024 * 2, WT_PLE = WT_D2 + (size_t)1024 * 2816 * 2, WT_LAYER = WT_PLE + (size_t)2048 * 1280 * 2;
static_assert(WT_LAYER <= 48 * MiB, "weights");
constexpr size_t WS_XB = 52 * MiB;
constexpr size_t WS_BIG = 432 * MiB;
constexpr size_t WS_O = 880 * MiB;
constexpr size_t WS_XBUF = 1008 * MiB;
constexpr size_t WS_END = 1010 * MiB;
constexpr size_t WS_LNCNT = 16384;
constexpr size_t CTL_BYTES = 512 * 1024;
constexpr size_t NUG = 6144, NUR = 4096;
constexpr size_t SC_GW = 0, SC_GQK = SC_GW + NUG * 8192, SC_GQ = SC_GQK + NUG * 8192, SC_GKT = SC_GQ + NUG * 8192, SC_GU = SC_GKT + NUG * 8192, SC_GVEC = SC_GU + NUG * 8192,
                 SC_RSC = SC_GVEC + NUG * 1024, SC_RQX = SC_RSC + NUR * 8192, SC_RKT = SC_RQX + NUR * 8192, SC_RVT = SC_RKT + NUR * 8192,
                 SC_LSH = SC_RVT + NUR * 8192, SC_LSA = SC_LSH + (size_t)8 * 128 * 384 * 4, SC_END = SC_LSA + (size_t)8 * 128 * 384 * 4;
static_assert(WS_XB + SC_END <= WS_BIG, "mixer scratch");

constexpr int LDS_BYTES = 147456;
constexpr int NPH = 17;

struct Args { const void* in[31]; float* out; unsigned char* ws; int ph_lo, ph_hi; };

__device__ __forceinline__ unsigned f2bf(float f) { unsigned u = __builtin_bit_cast(unsigned, f); return (u + 0x7fffu + ((u >> 16) & 1u)) >> 16; }
__device__ __forceinline__ unsigned pk2(float lo, float hi) { return f2bf(lo) | (f2bf(hi) << 16); }
__device__ __forceinline__ float bf2f(bf16_t u) { return __builtin_bit_cast(float, (unsigned)u << 16); }
__device__ __forceinline__ float sigmoidf_(float x) { return __builtin_amdgcn_rcpf(1.0f + __expf(-x)); }
__device__ __forceinline__ float siluf_(float x) { return x * __builtin_amdgcn_rcpf(1.0f + __expf(-x)); }
__device__ __forceinline__ float log1p_pos(float e) { const float z = e * __builtin_amdgcn_rcpf(2.0f + e), z2 = z * z; const float sr = 2.0f * z * (1.0f + z2 * (0.333333333f + z2 * (0.2f + z2 * (0.142857143f + z2 * 0.111111111f)))); return e < 0.25f ? sr : __logf(1.0f + e); }
__device__ __forceinline__ float one_minus_exp(float y) { const float sr = -y * (1.0f + y * (0.5f + y * (0.166666667f + y * (0.0416666667f + y * 0.00833333333f)))); return y > -0.1f ? sr : 1.0f - __expf(y); }
__device__ __forceinline__ float gelu_tanh(float x) { const float u = 0.7978845608028654f * (x + 0.044715f * x * x * x); const float e = __expf(2.0f * u); const float th = 1.0f - 2.0f * __builtin_amdgcn_rcpf(e + 1.0f); return 0.5f * x * (1.0f + th); }
__device__ __forceinline__ bf16x8 pack8(f32x4 a, f32x4 b) { u32x4 w; w.x = pk2(a.x, a.y); w.y = pk2(a.z, a.w); w.z = pk2(b.x, b.y); w.w = pk2(b.z, b.w); return __builtin_bit_cast(bf16x8, w); }
__device__ __forceinline__ f32x4 unpack4(bf16x4 v) { f32x4 r; r.x = bf2f((bf16_t)v.x); r.y = bf2f((bf16_t)v.y); r.z = bf2f((bf16_t)v.z); r.w = bf2f((bf16_t)v.w); return r; }
__device__ __forceinline__ float wave_sum(float v) {
#pragma unroll
    for (int o = 1; o < 64; o <<= 1) v += __shfl_xor(v, o);
    return v;
}
__device__ __forceinline__ float lane_read(float v, int srclane) { return __builtin_bit_cast(float, __builtin_amdgcn_ds_bpermute(srclane << 2, __builtin_bit_cast(int, v))); }
__device__ __forceinline__ float quad_sum(float v) {
    v += __builtin_bit_cast(float, __builtin_amdgcn_update_dpp(0, __builtin_bit_cast(int, v), 0xB1, 0xF, 0xF, true));
    v += __builtin_bit_cast(float, __builtin_amdgcn_update_dpp(0, __builtin_bit_cast(int, v), 0x4E, 0xF, 0xF, true));
    return v;
}
__device__ __forceinline__ float row16_sum(float v) {
    v += __builtin_bit_cast(float, __builtin_amdgcn_update_dpp(0, __builtin_bit_cast(int, v), 0xB1, 0xF, 0xF, true));
    v += __builtin_bit_cast(float, __builtin_amdgcn_update_dpp(0, __builtin_bit_cast(int, v), 0x4E, 0xF, 0xF, true));
    v += __builtin_bit_cast(float, __builtin_amdgcn_update_dpp(0, __builtin_bit_cast(int, v), 0x141, 0xF, 0xF, true));
    v += __builtin_bit_cast(float, __builtin_amdgcn_update_dpp(0, __builtin_bit_cast(int, v), 0x140, 0xF, 0xF, true));
    return v;
}
__device__ __forceinline__ int frag_off(int row, int col) { const int mt = row >> 4, r = row & 15, ks = col >> 5, hi = (col >> 4) & 1, q = (col >> 2) & 3, lo = col & 3; return ((mt * 2 + ks) * 64 + q * 16 + r) * 8 + hi * 4 + lo; }
__device__ __forceinline__ int cfrag_off(int c, int e) { const int mt = c >> 4, q = (c >> 2) & 3, j = c & 3; return ((mt * 4 + (e >> 4)) * 64 + q * 16 + (e & 15)) * 4 + j; }
__device__ __forceinline__ int bfrag_off(int c, int e) { const int ks = c >> 5, hi = (c >> 4) & 1, q = (c >> 2) & 3, lo = c & 3; return ((ks * 4 + (e >> 4)) * 64 + q * 16 + (e & 15)) * 8 + hi * 4 + lo; }

__constant__ double INVF_REV[32] = {1.59154943091895346e-01, 1.19349370211248862e-01, 8.94994016088910133e-02, 6.71150830052272551e-02, 5.03292121044870353e-02, 3.77415847174197711e-02, 2.83021958306233987e-02, 2.12236527647776604e-02, 1.59154943091895339e-02, 1.19349370211248862e-02, 8.94994016088910237e-03, 6.71150830052272534e-03, 5.03292121044870370e-03, 3.77415847174197719e-03, 2.83021958306233987e-03, 2.12236527647776622e-03, 1.59154943091895356e-03, 1.19349370211248849e-03, 8.94994016088910237e-04, 6.71150830052272599e-04, 5.03292121044870326e-04, 3.77415847174197741e-04, 2.83021958306233954e-04, 2.12236527647776605e-04, 1.59154943091895351e-04, 1.19349370211248862e-04, 8.94994016088910182e-05, 6.71150830052272545e-05, 5.03292121044870354e-05, 3.77415847174197768e-05, 2.83021958306233961e-05, 2.12236527647776592e-05};

namespace pg8 {
constexpr int BM = 256, BK = 64, HALF = 128, HTB = HALF * BK * 2, STAGE_BYTES = 8 * HTB, NXCD = 8, WGM = 8;
__device__ __forceinline__ int lds_byte(int r, int c) { const int st = (r >> 4) * 2 + (c >> 5), rr = r & 15, cc = c & 31, ob = rr * 64 + cc * 2; return st * 1024 + (ob ^ (((ob >> 9) & 1) << 5)); }
__device__ __forceinline__ void stage_rc(int b, int& R, int& C) { const int st = b / 1024, sb = b % 1024, swz = sb ^ (((sb >> 9) & 1) << 5); R = (st >> 1) * 16 + swz / 64; C = (st & 1) * 32 + (swz % 64) / 2; }
__device__ __forceinline__ int perm32(int rho) { const int n = rho >> 4, i = rho & 15; return 8 * (i >> 2) + 4 * n + (i & 3); }
struct Unit { int pm, pn; };
struct Gemm { const bf16_t* A; const bf16_t* Bt; };
struct StaticOrder {
    int nM, nN, nwg, G, c;
    __device__ void init(int M_, int N_, int G_, int c_) { nM = M_ / BM; nN = N_ / BM; nwg = nM * nN; G = G_; c = c_; }
    __device__ bool next(int i, Unit& u) const {
        const long L = (long)i * G + c; if (L >= nwg) return false;
        int wgid = (int)L; { const int q = nwg / NXCD, r = nwg % NXCD, xcd = wgid % NXCD, off = wgid / NXCD; wgid = (xcd < r ? xcd * (q + 1) : r * (q + 1) + (xcd - r) * q) + off; }
        const int nig = WGM * nN, gid = wgid / nig, fm = gid * WGM, gsz = (nM - fm) < WGM ? (nM - fm) : WGM;
        u.pm = fm + ((wgid % nig) % gsz); u.pn = (wgid % nig) / gsz; return true;
    }
};
struct EpiBf16 {
    static constexpr bool PERM = true;
    bf16_t* O; int ldc;
    __device__ __forceinline__ void operator()(const f32x4 (&acc)[2][2][4][2], const Unit& u, int wr, int wc, int fr, int fq) const {
        const int row0 = u.pm * BM + wr * 64 + fr, col0 = u.pn * BM + wc * 32 + 8 * fq;
#pragma unroll
        for (int ai = 0; ai < 2; ++ai)
#pragma unroll
            for (int m = 0; m < 4; ++m) { bf16_t* rowp = O + (size_t)(row0 + ai * HALF + m * 16) * ldc + col0;
#pragma unroll
                for (int bj = 0; bj < 2; ++bj) { const f32x4 v0 = acc[ai][bj][m][0], v1 = acc[ai][bj][m][1];
                    u32x4 w; w.x = pk2(v0[0], v0[1]); w.y = pk2(v0[2], v0[3]); w.z = pk2(v1[0], v1[1]); w.w = pk2(v1[2], v1[3]);
                    *(u32x4*)(rowp + bj * HALF) = w; } }
    }
};
template <int ACT  > struct EpiGated {
    static constexpr bool PERM = true;
    bf16_t* O; int ldc;
    __device__ __forceinline__ void operator()(const f32x4 (&acc)[2][2][4][2], const Unit& u, int wr, int wc, int fr, int fq) const {
        const int row0 = u.pm * BM + wr * 64 + fr, col0 = u.pn * HALF + wc * 32 + 8 * fq;
#pragma unroll
        for (int ai = 0; ai < 2; ++ai)
#pragma unroll
            for (int m = 0; m < 4; ++m) { bf16_t* rowp = O + (size_t)(row0 + ai * HALF + m * 16) * ldc + col0;
                float h[8];
#pragma unroll
                for (int n = 0; n < 2; ++n)
#pragma unroll
                    for (int j = 0; j < 4; ++j) { const float g = acc[ai][0][m][n][j], up = acc[ai][1][m][n][j]; const float s = __builtin_amdgcn_rcpf(1.0f + __expf(-g)); h[n * 4 + j] = (ACT == 0 ? g * s : s) * up; }
                u32x4 w; w.x = pk2(h[0], h[1]); w.y = pk2(h[2], h[3]); w.z = pk2(h[4], h[5]); w.w = pk2(h[6], h[7]);
                *(u32x4*)rowp = w; }
    }
};
struct EpiResid {
    static constexpr bool PERM = false;
    const float* resid; float* out; const bf16_t* ple; float s;
    __device__ __forceinline__ void operator()(const f32x4 (&acc)[2][2][4][2], const Unit& u, int wr, int wc, int fr, int fq) const {
        const int col0 = u.pn * BM + wc * 32 + 4 * fq;
#pragma unroll
        for (int ai = 0; ai < 2; ++ai)
#pragma unroll
            for (int m = 0; m < 4; ++m) { const size_t off = (size_t)(u.pm * BM + ai * HALF + wr * 64 + m * 16 + fr) * DM + col0;
#pragma unroll
                for (int bj = 0; bj < 2; ++bj)
#pragma unroll
                    for (int n = 0; n < 2; ++n) { const size_t o2 = off + bj * HALF + n * 16; const f32x4 x = *(const f32x4*)(resid + o2); f32x4 o = x * ALPHA + acc[ai][bj][m][n] * s;
                        if (ple) { const bf16x4 pv = *(const bf16x4*)(ple + o2); o = o + unpack4(pv); }
                        *(f32x4*)(out + o2) = o; } }
    }
};

template <bool HAS_PLE> struct EpiResidLN {
    static constexpr bool PERM = false;
    const float* resid; float* out; bf16_t* xb; const bf16_t* ple; const float* pin; float s;
    const float* g; const float* b; unsigned long long* xbuf; unsigned* cnt; LAS unsigned char* lds;
    __device__ __forceinline__ void operator()(f32x4 (&acc)[2][2][4][2], const Unit& u, int wr, int wc, int fr0, int fq0) const {
        typedef float f32x2v __attribute__((ext_vector_type(2)));
        int fr = fr0, fq = fq0; asm volatile("" : "+v"(fr), "+v"(fq));
        LAS f32x2v* P = (LAS f32x2v*)lds;
        LAS f32x2v* S = (LAS f32x2v*)(lds + 8192);
        const int wid = wr * 4 + wc, lane = fq * 16 + fr;
        const int col0 = u.pn * BM + wc * 32 + 4 * fq;
#pragma unroll
        for (int ai = 0; ai < 2; ++ai)
#pragma unroll
            for (int m = 0; m < 4; ++m) { f32x4 rv[2][2]; bf16x4 pv[2][2]; const size_t off = (size_t)(u.pm * BM + ai * HALF + wr * 64 + m * 16 + fr) * DM + col0;
#pragma unroll
                for (int bj = 0; bj < 2; ++bj)
#pragma unroll
                    for (int n = 0; n < 2; ++n) { const size_t o2 = off + bj * HALF + n * 16; rv[bj][n] = *(const f32x4*)(resid + o2); if (HAS_PLE) pv[bj][n] = *(const bf16x4*)(ple + o2); }
#pragma unroll
                for (int bj = 0; bj < 2; ++bj)
#pragma unroll
                    for (int n = 0; n < 2; ++n) { f32x4 o = rv[bj][n] * ALPHA + acc[ai][bj][m][n] * s; if (HAS_PLE) o = o + unpack4(pv[bj][n]); acc[ai][bj][m][n] = o; }
                asm volatile("" : "+v"(acc[ai][0][m][0]), "+v"(acc[ai][0][m][1]), "+v"(acc[ai][1][m][0]), "+v"(acc[ai][1][m][1]));
                asm volatile("" ::: "memory"); }
#pragma unroll
        for (int ai = 0; ai < 2; ++ai)
#pragma unroll
            for (int m = 0; m < 4; ++m) { float sm = 0.f;
#pragma unroll
                for (int bj = 0; bj < 2; ++bj)
#pragma unroll
                    for (int n = 0; n < 2; ++n) { const f32x4 x = acc[ai][bj][m][n]; sm += (x[0] + x[1]) + (x[2] + x[3]); }
                sm += lane_read(sm, lane ^ 16); sm += lane_read(sm, lane ^ 32);
                const float mw = sm * (1.0f / 64.0f); float qq = 0.f;
#pragma unroll
                for (int bj = 0; bj < 2; ++bj)
#pragma unroll
                    for (int n = 0; n < 2; ++n) { const f32x4 d = acc[ai][bj][m][n] - mw; qq += (d[0] * d[0] + d[1] * d[1]) + (d[2] * d[2] + d[3] * d[3]); }
                qq += lane_read(qq, lane ^ 16); qq += lane_read(qq, lane ^ 32);
                if (fq == 0) P[(ai * HALF + wr * 64 + m * 16 + fr) * 4 + wc] = (f32x2v){mw, qq}; }
        asm volatile("s_waitcnt lgkmcnt(0)\n\ts_barrier" ::: "memory");
        const int row = wid * 32 + (lane & 31);
        if (lane < 32) { const f32x2v a = P[row * 4 + 0], bb = P[row * 4 + 1], c = P[row * 4 + 2], d = P[row * 4 + 3];
            const float mt = (a.x + bb.x + c.x + d.x) * 0.25f; const float da = a.x - mt, db = bb.x - mt, dc = c.x - mt, dd = d.x - mt;
            const float m2 = (a.y + bb.y) + (c.y + d.y) + 64.0f * ((da * da + db * db) + (dc * dc + dd * dd));
            unsigned long long* slot = xbuf + ((size_t)(u.pm * BM + row) * 4 + u.pn);
            __hip_atomic_store(slot, ((unsigned long long)__builtin_bit_cast(unsigned, m2) << 32) | __builtin_bit_cast(unsigned, mt), __ATOMIC_RELAXED, __HIP_MEMORY_SCOPE_AGENT); }
        asm volatile("s_waitcnt vmcnt(0)" ::: "memory");
        if (lane == 0) __hip_atomic_fetch_add(cnt + 64 * u.pm, 1u, __ATOMIC_RELAXED, __HIP_MEMORY_SCOPE_AGENT);
        f32x4 g4v[2][2], b4v[2][2];
#pragma unroll
        for (int bj = 0; bj < 2; ++bj)
#pragma unroll
            for (int n = 0; n < 2; ++n) { const int col = col0 + bj * HALF + n * 16; g4v[bj][n] = *(const f32x4*)(g + col); b4v[bj][n] = *(const f32x4*)(b + col); }
        if (wid == 0) { while ((unsigned)__builtin_amdgcn_readfirstlane(__hip_atomic_load(cnt + 64 * u.pm, __ATOMIC_RELAXED, __HIP_MEMORY_SCOPE_AGENT)) < 32u) __builtin_amdgcn_s_sleep(1);
            __builtin_amdgcn_fence(__ATOMIC_ACQUIRE, "agent"); }
        asm volatile("s_waitcnt vmcnt(0) lgkmcnt(0)\n\ts_barrier" ::: "memory");
        if (lane < 32) { const unsigned long long* slot = xbuf + (size_t)(u.pm * BM + row) * 4; float mt[4], m2[4]; float ms = 0.f;
            unsigned long long w4[4];
#pragma unroll
            for (int t = 0; t < 4; ++t) w4[t] = __hip_atomic_load(slot + t, __ATOMIC_RELAXED, __HIP_MEMORY_SCOPE_AGENT);
            __builtin_amdgcn_sched_barrier(0);
#pragma unroll
            for (int t = 0; t < 4; ++t) { mt[t] = __builtin_bit_cast(float, (unsigned)w4[t]); m2[t] = __builtin_bit_cast(float, (unsigned)(w4[t] >> 32)); ms += mt[t]; }
            const float mean = ms * 0.25f; float qv = 0.f;
#pragma unroll
            for (int t = 0; t < 4; ++t) { const float dm = mt[t] - mean; qv += m2[t] + 256.0f * dm * dm; }
            S[row] = (f32x2v){mean, __builtin_amdgcn_rsqf(qv * (1.0f / 1024.0f) + LN_EPS)}; }
        asm volatile("s_waitcnt vmcnt(0) lgkmcnt(0)\n\ts_barrier" ::: "memory");
#pragma unroll
        for (int bj = 0; bj < 2; ++bj)
#pragma unroll
            for (int n = 0; n < 2; ++n) { const int col = col0 + bj * HALF + n * 16; const f32x4 g4 = g4v[bj][n], b4 = b4v[bj][n];
#pragma unroll
                for (int ai = 0; ai < 2; ++ai)
#pragma unroll
                    for (int m = 0; m < 4; ++m) { const int r = ai * HALF + wr * 64 + m * 16 + fr; const f32x2v sr = S[r]; const size_t grow = (size_t)(u.pm * BM + r);
                        const f32x4 y = (acc[ai][bj][m][n] - sr.x) * sr.y * g4 + b4;
                        *(f32x4*)(out + grow * DM + col) = y; u32x2 w; w.x = pk2(y[0], y[1]); w.y = pk2(y[2], y[3]); *(u32x2*)(xb + grow * XBLD + col) = w; } }
        if (pin) { f32x4 pv8[8];
#pragma unroll
            for (int i = 0; i < 8; ++i) { const int idx = wid * 64 + lane + 512 * i, rr = idx >> 4, c4 = idx & 15; pv8[i] = *(const f32x4*)(pin + (size_t)(u.pm * BM + rr) * 256 + 64 * u.pn + 4 * c4); }
#pragma unroll
            for (int i = 0; i < 8; ++i) { const int idx = wid * 64 + lane + 512 * i, rr = idx >> 4, c4 = idx & 15; const f32x4 pv = pv8[i];
                u32x2 w; w.x = pk2(pv[0], pv[1]); w.y = pk2(pv[2], pv[3]); *(u32x2*)(xb + (size_t)(u.pm * BM + rr) * XBLD + 1024 + 64 * u.pn + 4 * c4) = w; } }
    }
};

template <int LDA, int LDB, int KK, class Epi, int SPLIT_T = 0>
__device__ __forceinline__ void gemm_phase(LAS unsigned char* lds, const int tid, const Gemm g, const StaticOrder& S, const Epi& E) {
    const int  wid = __builtin_amdgcn_readfirstlane(tid >> 6), lane = tid & 63, wr = wid >> 2, wc = wid & 3, fr = lane & 15, fq = lane >> 4;
    constexpr int nt = KK / BK;
    unsigned voffA[2], voffB[2];
#pragma unroll
    for (int i = 0; i < 2; ++i) { int R, C; stage_rc(tid * 16 + i * 8192, R, C); const int Rb = Epi::PERM ? ((R & ~31) + perm32(R & 31)) : R;
        voffA[i] = (unsigned)(R * LDA + C) * 2u; voffB[i] = (unsigned)(Rb * LDB + C) * 2u; }
    constexpr size_t kstep = (size_t)(BK * 2);
    constexpr size_t hstepA = (size_t)HALF * LDA * 2, hstepB = (size_t)HALF * LDB * 2;
    constexpr size_t tstepA = 2 * hstepA, tstepB = 2 * hstepB;
    const unsigned ldsw = (unsigned)wid * 1024u;
    const int aoff = lds_byte(wr * 64 + fr, fq * 8), boff = lds_byte(wc * 32 + fr, fq * 8);
#define PG8_SA(b, h) (((b) * 2 + (h)) * HTB)
#define PG8_SB(b, h) ((4 + (b) * 2 + (h)) * HTB)
#define PG8_STAGE(bufoff, gbase, voff) do { _Pragma("unroll") for (int _i = 0; _i < 2; ++_i) \
        __builtin_amdgcn_global_load_lds((const unsigned*)((const char*)(gbase) + (voff)[_i]), (LAS unsigned*)(lds + (bufoff) + ldsw + _i * 8192), 16, 0, 0); } while (0)
#define PG8_LDA(dst, b, h) do { _Pragma("unroll") for (int m = 0; m < 4; ++m) _Pragma("unroll") for (int k = 0; k < 2; ++k) dst[m][k] = *(const LAS bf16x8*)(lds + PG8_SA(b, h) + aoff + m * 2048 + k * 1024); } while (0)
#define PG8_LDB(dst, b, h) do { _Pragma("unroll") for (int n = 0; n < 2; ++n) _Pragma("unroll") for (int k = 0; k < 2; ++k) dst[n][k] = *(const LAS bf16x8*)(lds + PG8_SB(b, h) + boff + n * 2048 + k * 1024); } while (0)
#define PG8_MMA(ai, bj, At, Bt) do { __builtin_amdgcn_s_setprio(1); _Pragma("unroll") for (int m = 0; m < 4; ++m) _Pragma("unroll") for (int n = 0; n < 2; ++n) _Pragma("unroll") for (int k = 0; k < 2; ++k) \
        acc[ai][bj][m][n] = __builtin_amdgcn_mfma_f32_16x16x32_bf16(Bt[n][k], At[m][k], acc[ai][bj][m][n], 0, 0, 0); __builtin_amdgcn_s_setprio(0); } while (0)
#define PG8_WAIT_V(n) asm volatile("s_waitcnt vmcnt(" #n ")" ::: "memory")
#define PG8_WAIT_L(n) asm volatile("s_waitcnt lgkmcnt(" #n ")" ::: "memory")
#define PG8_BAR __builtin_amdgcn_s_barrier()
#define PG8_SCHED __builtin_amdgcn_sched_barrier(0)
    Unit cur, nxt; int ui = 0;
    if (!S.next(0, cur)) return;
    f32x4 acc[2][2][4][2];
#pragma unroll
    for (int a = 0; a < 2; ++a)
#pragma unroll
        for (int b = 0; b < 2; ++b)
#pragma unroll
            for (int m = 0; m < 4; ++m)
#pragma unroll
                for (int n = 0; n < 2; ++n) acc[a][b][m][n] = (f32x4){0.f, 0.f, 0.f, 0.f};
    bf16x8 At[4][2], B0[2][2], B1[2][2];
    const char* cA = (const char*)g.A + (size_t)cur.pm * tstepA; const char* cB = (const char*)g.Bt + (size_t)cur.pn * tstepB;
    PG8_STAGE(PG8_SB(0, 0), cB, voffB); PG8_STAGE(PG8_SB(0, 1), cB + hstepB, voffB); PG8_STAGE(PG8_SA(0, 0), cA, voffA); PG8_STAGE(PG8_SA(0, 1), cA + hstepA, voffA);
    if (wr == 1) PG8_BAR;
    PG8_WAIT_V(2); PG8_BAR;
    PG8_STAGE(PG8_SB(1, 0), cB + kstep, voffB); PG8_STAGE(PG8_SA(1, 0), cA + kstep, voffA); PG8_STAGE(PG8_SB(1, 1), cB + hstepB + kstep, voffB);
    PG8_WAIT_V(6); PG8_BAR;
    for (;;) {
        const bool has_next = S.next(ui + 1, nxt);
        const char* nA = has_next ? (const char*)g.A + (size_t)nxt.pm * tstepA : cA; const char* nB = has_next ? (const char*)g.Bt + (size_t)nxt.pn * tstepB : cB;
        for (int t = 0; t < nt; t += 2) {
            const bool last = (t == nt - 2);
            const char* a1 = cA + (size_t)(t + 1) * kstep;
            const char* a2 = last ? nA : cA + (size_t)(t + 2) * kstep; const char* b2 = last ? nB : cB + (size_t)(t + 2) * kstep;
            const char* a3 = a2 + kstep; const char* b3 = b2 + kstep;
            PG8_LDB(B0, 0, 0); PG8_LDB(B1, 0, 1); PG8_SCHED; PG8_LDA(At, 0, 0); PG8_STAGE(PG8_SA(1, 1), a1 + hstepA, voffA);
            PG8_WAIT_V(8); PG8_WAIT_L(0); PG8_BAR; if (SPLIT_T == 0 || t < SPLIT_T) PG8_MMA(0, 0, At, B0); if (SPLIT_T == 0 || t >= SPLIT_T) PG8_MMA(0, 1, At, B1); PG8_BAR; PG8_SCHED;
            PG8_LDA(At, 0, 1); PG8_STAGE(PG8_SB(0, 0), b2, voffB); PG8_STAGE(PG8_SB(0, 1), b2 + hstepB, voffB); PG8_STAGE(PG8_SA(0, 0), a2, voffA);
            PG8_WAIT_V(8); PG8_WAIT_L(0); PG8_BAR; if (SPLIT_T == 0 || t < SPLIT_T) PG8_MMA(1, 0, At, B0); if (SPLIT_T == 0 || t >= SPLIT_T) PG8_MMA(1, 1, At, B1); PG8_BAR; PG8_SCHED;
            PG8_LDB(B0, 1, 0); PG8_LDB(B1, 1, 1); PG8_SCHED; PG8_LDA(At, 1, 0); PG8_STAGE(PG8_SA(0, 1), a2 + hstepA, voffA);
            PG8_WAIT_V(8); PG8_WAIT_L(0); PG8_BAR; if (SPLIT_T == 0 || t < SPLIT_T) PG8_MMA(0, 0, At, B0); if (SPLIT_T == 0 || t >= SPLIT_T) PG8_MMA(0, 1, At, B1); PG8_BAR; PG8_SCHED;
            PG8_LDA(At, 1, 1); PG8_STAGE(PG8_SB(1, 0), b3, voffB); PG8_STAGE(PG8_SB(1, 1), b3 + hstepB, voffB); PG8_STAGE(PG8_SA(1, 0), a3, voffA);
            PG8_WAIT_V(8); PG8_WAIT_L(0); PG8_BAR; if (SPLIT_T == 0 || t < SPLIT_T) PG8_MMA(1, 0, At, B0); if (SPLIT_T == 0 || t >= SPLIT_T) PG8_MMA(1, 1, At, B1); PG8_BAR; PG8_SCHED;
        }
        if (wr == 0) PG8_BAR;
        E(acc, cur, wr, wc, fr, fq);
        if (!has_next) break;
#pragma unroll
        for (int a = 0; a < 2; ++a)
#pragma unroll
            for (int b = 0; b < 2; ++b)
#pragma unroll
                for (int m = 0; m < 4; ++m)
#pragma unroll
                    for (int n = 0; n < 2; ++n) acc[a][b][m][n] = (f32x4){0.f, 0.f, 0.f, 0.f};
        cur = nxt; cA = nA; cB = nB; ++ui;
        if (wr == 1) PG8_BAR;
    }
    PG8_WAIT_V(0);
    PG8_BAR;
#undef PG8_SA
#undef PG8_SB
#undef PG8_STAGE
#undef PG8_LDA
#undef PG8_LDB
#undef PG8_MMA
#undef PG8_WAIT_V
#undef PG8_WAIT_L
#undef PG8_BAR
#undef PG8_SCHED
}
}

struct Frame {
    LAS unsigned char* lds; float* ldsf;
    int tid, lane, wave, G, bid; GAS unsigned char* ws; const CAS struct Args* ap;
};

__device__ __forceinline__ void conv_mat(const Frame& F, const float* W, int K, int N, int Ndst, bf16_t* dst, int ldd, int kofs, int mode) {
    const int gw = F.bid * 8 + F.wave, NGW = F.G * 8;
    const int nblk = Ndst / 8, kblk = K / 64, items = nblk * kblk;
    const int nl = F.lane >> 3, kc = F.lane & 7;
    for (int it = gw; it < items; it += NGW) {
        const int nb = it % nblk, kb = it / nblk; const int n = nb * 8 + nl, k0 = kb * 64 + kc * 8;
        const int nc = n < N ? n : N - 1;
        float v[8];
#pragma unroll
        for (int kk = 0; kk < 8; ++kk) v[kk] = W[(size_t)(k0 + kk) * N + nc];
        const float zf = n < N ? 1.0f : 0.0f;
        const int row = (mode == 0) ? n : ((n >> 7) * 256 + (n & 127) + (mode == 2 ? 128 : 0));
        u32x4 w; w.x = pk2(v[0] * zf, v[1] * zf); w.y = pk2(v[2] * zf, v[3] * zf); w.z = pk2(v[4] * zf, v[5] * zf); w.w = pk2(v[6] * zf, v[7] * zf);
        *(u32x4*)(dst + (size_t)row * ldd + kofs + k0) = w;
    }
}
__device__ __forceinline__ void p_convert_weights(Frame& F, int l, int parts) {
    const int gw = F.bid * 8 + F.wave, NGW = F.G * 8;
    unsigned char* wt = (unsigned char*)(F.ws + WS_WT);
    if (parts & 1) {
    conv_mat(F, ((const float*)(const GAS float*)F.ap->in[5]) + (size_t)l * DM * DFF, DM, DFF, DFF, (bf16_t*)(wt + WT_GU1), DM, 0, 1);
    conv_mat(F, ((const float*)(const GAS float*)F.ap->in[6]) + (size_t)l * DM * DFF, DM, DFF, DFF, (bf16_t*)(wt + WT_GU1), DM, 0, 2);
    conv_mat(F, ((const float*)(const GAS float*)F.ap->in[7]) + (size_t)l * DFF * DM, DFF, DM, DM, (bf16_t*)(wt + WT_D1), DFF, 0, 0);
    conv_mat(F, ((const float*)(const GAS float*)F.ap->in[8]) + (size_t)l * DM * DIN, DM, DIN, DINP, (bf16_t*)(wt + WT_IN), DM, 0, 0);
    conv_mat(F, ((const float*)(const GAS float*)F.ap->in[21]) + (size_t)l * DM * DM, DM, DM, DM, (bf16_t*)(wt + WT_OUT), DM, 0, 0);
    }
    if (parts & 2) {
    conv_mat(F, ((const float*)(const GAS float*)F.ap->in[24]) + (size_t)l * DM * DFF, DM, DFF, DFF, (bf16_t*)(wt + WT_GU2), DM, 0, 1);
    conv_mat(F, ((const float*)(const GAS float*)F.ap->in[25]) + (size_t)l * DM * DFF, DM, DFF, DFF, (bf16_t*)(wt + WT_GU2), DM, 0, 2);
    conv_mat(F, ((const float*)(const GAS float*)F.ap->in[26]) + (size_t)l * DFF * DM, DFF, DM, DM, (bf16_t*)(wt + WT_D2), DFF, 0, 0);
    conv_mat(F, ((const float*)(const GAS float*)F.ap->in[27]) + (size_t)l * DM * DM, DM, DM, DM, (bf16_t*)(wt + WT_PLE), XBLD, 0, 1);
    conv_mat(F, ((const float*)(const GAS float*)F.ap->in[28]) + (size_t)l * 256 * DM, 256, DM, DM, (bf16_t*)(wt + WT_PLE), XBLD, 1024, 2);
    bf16_t* wp = (bf16_t*)(wt + WT_PLE);
    for (int it = gw * 64 + F.lane; it < 2048 * 160; it += NGW * 64) { const int row = it / 160, ch = it % 160; const bool isproj = (row >> 7) & 1; const bool z = isproj ? (ch < 128) : (ch >= 128);
        if (z) *(u32x4*)(wp + (size_t)row * XBLD + ch * 8) = (u32x4){0u, 0u, 0u, 0u}; }
    }
}
__device__ __forceinline__ void p_prologue(Frame& F) {
    const int gw = F.bid * 8 + F.wave, NGW = F.G * 8;
    p_convert_weights(F, 0, 3);
    const float* x = ((const float*)(const GAS float*)F.ap->in[0]);
    for (int m = gw; m < M; m += NGW) { const f32x4* xr = (const f32x4*)(x + (size_t)m * DM) + F.lane; u32x2* o = (u32x2*)(((bf16_t*)((unsigned char*)(F.ws + WS_XB))) + (size_t)m * XBLD) + F.lane;
#pragma unroll
        for (int j = 0; j < 4; ++j) { const f32x4 v = xr[64 * j]; u32x2 w; w.x = pk2(v.x, v.y); w.y = pk2(v.z, v.w); o[64 * j] = w; } }
}
__device__ __forceinline__ void p_layernorm(Frame& F, const float* g, const float* b, const float* pl) {
    const int gw = F.bid * 8 + F.wave, NGW = F.G * 8;
    f32x4 g4[4], b4[4];
#pragma unroll
    for (int j = 0; j < 4; ++j) { g4[j] = ((const f32x4*)g)[F.lane + 64 * j]; b4[j] = ((const f32x4*)b)[F.lane + 64 * j]; }
    for (int m = gw; m < M; m += NGW) {
        f32x4* xr = (f32x4*)(((float*)(GAS float*)F.ap->out) + (size_t)m * DM) + F.lane;
        f32x4 v[4]; float s = 0.f;
#pragma unroll
        for (int j = 0; j < 4; ++j) { v[j] = xr[64 * j]; s += (v[j].x + v[j].y) + (v[j].z + v[j].w); }
        const float mean = wave_sum(s) * (1.f / DM); float s2 = 0.f;
#pragma unroll
        for (int j = 0; j < 4; ++j) { v[j] = v[j] - mean; s2 += (v[j].x * v[j].x + v[j].y * v[j].y) + (v[j].z * v[j].z + v[j].w * v[j].w); }
        const float rstd = __builtin_amdgcn_rsqf(wave_sum(s2) * (1.f / DM) + LN_EPS);
        u32x2* o = (u32x2*)(((bf16_t*)((unsigned char*)(F.ws + WS_XB))) + (size_t)m * XBLD) + F.lane;
#pragma unroll
        for (int j = 0; j < 4; ++j) { const f32x4 y = v[j] * rstd * g4[j] + b4[j]; xr[64 * j] = y; u32x2 w; w.x = pk2(y.x, y.y); w.y = pk2(y.z, y.w); o[64 * j] = w; }
        if (pl) { const f32x4 pv = ((const f32x4*)(pl + (size_t)m * 256))[F.lane]; u32x2 w; w.x = pk2(pv.x, pv.y); w.y = pk2(pv.z, pv.w); o[256] = w; }
    }
}

#define LBAR() asm volatile("s_waitcnt lgkmcnt(0)\n\ts_barrier" ::: "memory")
constexpr int LS = 68;
__device__ __forceinline__ void dot_rows(const float* X, const float* Y, int iw, int j, float (&acc)[8]) {
#pragma unroll
    for (int ii = 0; ii < 8; ++ii) acc[ii] = 0.f;
#pragma unroll 4
    for (int d4 = 0; d4 < 16; ++d4) { const f32x4 y = *(const f32x4*)(Y + j * LS + 4 * d4);
#pragma unroll
        for (int ii = 0; ii < 8; ++ii) { const f32x4 x = *(const f32x4*)(X + (iw + 8 * ii) * LS + 4 * d4); acc[ii] += (x.x * y.x + x.y * y.y) + (x.z * y.z + x.w * y.w); } }
}

constexpr int RP = 144;
__device__ __forceinline__ f32x4 tile_xyT(const float* X, const float* Y, int mt, int nt, int lane) {
    const int l15 = lane & 15, q = lane >> 4; f32x4 acc = {0.f, 0.f, 0.f, 0.f};
    const float* xa = X + (16 * mt + l15) * LS + 8 * q; const float* yb = Y + (16 * nt + l15) * LS + 8 * q;
    f32x4 xr[4], yr[4];
#pragma unroll
    for (int k = 0; k < 4; ++k) { xr[k] = *(const f32x4*)(xa + 32 * (k >> 1) + 4 * (k & 1)); yr[k] = *(const f32x4*)(yb + 32 * (k >> 1) + 4 * (k & 1)); }
    __builtin_amdgcn_sched_barrier(0);
#pragma unroll
    for (int ks = 0; ks < 2; ++ks) acc = __builtin_amdgcn_mfma_f32_16x16x32_bf16(pack8(xr[2 * ks], xr[2 * ks + 1]), pack8(yr[2 * ks], yr[2 * ks + 1]), acc, 0, 0, 0);
    return acc;
}
__device__ __forceinline__ void gdn_par_unit(Frame& F, int l, int b, int n, int h, int ul) {
    float* Q = F.ldsf; float* Kx = Q + 64 * LS; float* V = Kx + 64 * LS; float* A = V + 64 * LS; float* vec = A + 64 * LS;
    unsigned char* RAW = (unsigned char*)(vec + 320);
    bf16_t* STG = (bf16_t*)((unsigned char*)F.ldsf + 104704);
    int tid = F.tid; asm volatile("" : "+v"(tid));
    const bf16_t* hin = ((bf16_t*)(F.ws + WS_BIG)) + (size_t)b * SEQL * DINP;
    const float* cw = ((const float*)(const GAS float*)F.ap->in[17]) + (size_t)l * 4 * 1152;
    unsigned char* SCRB = (unsigned char*)(F.ws + WS_XB);
    u32x4* GW = (u32x4*)(SCRB + SC_GW) + (size_t)ul * 512; u32x4* GQK = (u32x4*)(SCRB + SC_GQK) + (size_t)ul * 512; u32x4* GQ = (u32x4*)(SCRB + SC_GQ) + (size_t)ul * 512;
    u32x4* GKT = (u32x4*)(SCRB + SC_GKT) + (size_t)ul * 512; u32x4* GU = (u32x4*)(SCRB + SC_GU) + (size_t)ul * 512; float* GV = (float*)(SCRB + SC_GVEC) + (size_t)ul * 256;
    { u32x4 r[4];
#pragma unroll
      for (int i = 0; i < 4; ++i) { const int p = tid + 512 * i, tsr = p / 536, rem = p - tsr * 536, row = rem >> 3, ch = rem & 7; const int tr = n * 64 - 3 + row;
          r[i] = (u32x4){0u, 0u, 0u, 0u};
          if (p < 1608 && tr >= 0) r[i] = *(const u32x4*)(hin + (size_t)tr * DINP + C_GQ + tsr * 384 + h * 64 + ch * 8); }
#pragma unroll
      for (int i = 0; i < 4; ++i) { const int p = tid + 512 * i, tsr = p / 536, rem = p - tsr * 536, row = rem >> 3, ch = rem & 7;
          if (p < 1608) *(u32x4*)(RAW + (tsr * 67 + row) * RP + ch * 16) = r[i]; } }
    float ag = 0.f, bg = 0.f;
    if (tid < 64) { const size_t ro = (size_t)(n * 64 + tid) * DINP; ag = bf2f(hin[ro + C_GA + h]); bg = bf2f(hin[ro + C_GB + h]); }
    const float dtb_ = ((const float*)(const GAS float*)F.ap->in[19])[l * 6 + h], alog_ = ((const float*)(const GAS float*)F.ap->in[18])[l * 6 + h];
    float cwv[3][4];
#pragma unroll
    for (int tsr = 0; tsr < 3; ++tsr)
#pragma unroll
        for (int kk = 0; kk < 4; ++kk) cwv[tsr][kk] = cw[kk * 1152 + tsr * 384 + h * 64 + (tid & 63)];
    LBAR();
    { const int d = tid & 63;
#pragma unroll
      for (int tsr = 0; tsr < 3; ++tsr) { const float w0 = cwv[tsr][0], w1 = cwv[tsr][1], w2 = cwv[tsr][2], w3 = cwv[tsr][3];
          const unsigned char* rb = RAW + tsr * 67 * RP + d * 2;
          bf16_t xr[8][4];
#pragma unroll
          for (int i = 0; i < 8; ++i)
#pragma unroll
              for (int kk = 0; kk < 4; ++kk) xr[i][kk] = *(const bf16_t*)(rb + ((tid >> 6) + 8 * i + kk) * RP);
          __builtin_amdgcn_sched_barrier(0);
#pragma unroll
          for (int i = 0; i < 8; ++i) { const int t = (tid >> 6) + 8 * i;
              const float sacc = (w0 * bf2f(xr[i][0]) + w1 * bf2f(xr[i][1])) + (w2 * bf2f(xr[i][2]) + w3 * bf2f(xr[i][3]));
              F.ldsf[tsr * 64 * LS + t * LS + d] = siluf_(sacc); }
          __builtin_amdgcn_sched_barrier(0); } }
    LBAR();
    { const int r = tid >> 2, part = tid & 3; float* p = F.ldsf + (r >> 6) * 64 * LS + (r & 63) * LS + part * 16; float ss = 0.f;
#pragma unroll
      for (int i = 0; i < 16; ++i) ss += p[i] * p[i];
      ss = quad_sum(ss);
      const float sc = __builtin_amdgcn_rsqf(ss + 1e-6f) * (r < 64 ? 0.125f : 1.0f);
#pragma unroll
      for (int i = 0; i < 16; ++i) p[i] *= sc; }
    if (tid < 64) { const float xs = ag + dtb_; const float sp = xs > 20.f ? xs : log1p_pos(__expf(xs));
        float v = -__expf(alog_) * sp; vec[tid] = v; vec[64 + tid] = sigmoidf_(bg);
#pragma unroll
        for (int o = 1; o < 64; o <<= 1) { const float u = lane_read(v, (tid - o) & 63); if (tid >= o) v += u; }
        const float gl = __builtin_bit_cast(float, __builtin_amdgcn_readlane(__builtin_bit_cast(int, v), 63)); const float eg = __expf(v), et = __expf(gl - v);
        vec[128 + tid] = v; vec[192 + tid] = eg; vec[256 + tid] = et; GV[tid] = eg; GV[64 + tid] = et; }
    LBAR();
    { const int mt = F.wave >> 1, l15 = F.lane & 15, q = F.lane >> 4;
      const f32x4 gci4 = *(const f32x4*)(vec + 128 + 16 * mt + 4 * q), bi4 = *(const f32x4*)(vec + 64 + 16 * mt + 4 * q);
      const float gcj0 = vec[128 + 32 * (F.wave & 1) + l15], gcj1 = vec[128 + 32 * (F.wave & 1) + 16 + l15];
#pragma unroll
      for (int t2 = 0; t2 < 2; ++t2) { const int nt = 2 * (F.wave & 1) + t2; const int j = 16 * nt + l15;
          f32x4 kkv = {0.f, 0.f, 0.f, 0.f}, qkv = {0.f, 0.f, 0.f, 0.f};
          if (nt <= mt) { kkv = tile_xyT(Kx, Kx, mt, nt, F.lane); qkv = tile_xyT(Q, Kx, mt, nt, F.lane); }
          const float gcj = t2 ? gcj1 : gcj0;
#pragma unroll
          for (int jj = 0; jj < 4; ++jj) { const int i = 16 * mt + 4 * q + jj; const float dec = (j <= i) ? __expf(fminf(gci4[jj] - gcj, 0.f)) : 0.f;
              A[i * LS + j] = (j < i) ? bi4[jj] * kkv[jj] * dec : 0.f;
              STG[frag_off(i, j)] = (bf16_t)f2bf(qkv[jj] * dec); } } }
    { float fv[16], fs[16];
#pragma unroll
      for (int i = 0; i < 16; ++i) { const int which = i >> 3, rem = tid + 512 * (i & 7), cc = rem >> 6, r = rem & 63;
          fv[i] = F.ldsf[which * 64 * LS + cc * LS + r]; fs[i] = vec[192 + 64 * which + cc]; }
      __builtin_amdgcn_sched_barrier(0);
#pragma unroll
      for (int i = 0; i < 16; ++i) fv[i] *= fs[i];
#pragma unroll
      for (int i = 0; i < 16; ++i) { const int which = i >> 3, rem = tid + 512 * (i & 7), cc = rem >> 6, r = rem & 63;
          if (which == 0) STG[4096 + frag_off(cc, r)] = (bf16_t)f2bf(fv[i]);
          else STG[8192 + frag_off(r, cc)] = (bf16_t)f2bf(fv[i]); } }
    LBAR();
    { const u32x4* sg = (const u32x4*)STG; GQK[tid] = sg[tid]; GQ[tid] = sg[512 + tid]; GKT[tid] = sg[1024 + tid]; }
    { constexpr int XL = 132; float* XS = vec + 320;
      { float xv[16];
        const bool isU = (F.wave & 1) == 0;
        const float* src0 = (isU ? V : Kx) + (tid & 63);
        float xb[16], xe[16];
#pragma unroll
        for (int i = 0; i < 16; ++i) { const int r = (tid >> 7) + 4 * i; xv[i] = src0[r * LS]; xb[i] = vec[64 + r]; xe[i] = vec[192 + r]; }
        __builtin_amdgcn_sched_barrier(0);
#pragma unroll
        for (int i = 0; i < 16; ++i) xv[i] = xv[i] * xb[i] * (isU ? 1.0f : xe[i]);
#pragma unroll
        for (int i = 0; i < 16; ++i) { const int idx = tid + 512 * i, r = idx >> 7, c = idx & 127; XS[r * XL + c] = xv[i]; } }
      LBAR();
#pragma unroll 1
      for (int ib = 0; ib < 4; ++ib) {
          if (ib > 0) { const int c = tid & 127, r0 = 16 * ib + (tid >> 7) * 4; float s0 = 0.f, s1 = 0.f, s2 = 0.f, s3 = 0.f;
#pragma unroll 2
              for (int j = 0; j < 16 * ib; j += 4) { const float x0 = XS[j * XL + c], x1 = XS[(j + 1) * XL + c], x2 = XS[(j + 2) * XL + c], x3 = XS[(j + 3) * XL + c];
                  const f32x4 a0 = *(const f32x4*)(A + r0 * LS + j), a1 = *(const f32x4*)(A + (r0 + 1) * LS + j), a2 = *(const f32x4*)(A + (r0 + 2) * LS + j), a3 = *(const f32x4*)(A + (r0 + 3) * LS + j);
                  s0 += (a0.x * x0 + a0.y * x1) + (a0.z * x2 + a0.w * x3); s1 += (a1.x * x0 + a1.y * x1) + (a1.z * x2 + a1.w * x3);
                  s2 += (a2.x * x0 + a2.y * x1) + (a2.z * x2 + a2.w * x3); s3 += (a3.x * x0 + a3.y * x1) + (a3.z * x2 + a3.w * x3); }
              XS[r0 * XL + c] -= s0; XS[(r0 + 1) * XL + c] -= s1; XS[(r0 + 2) * XL + c] -= s2; XS[(r0 + 3) * XL + c] -= s3;
              LBAR(); }
          {
              const int c = tid >> 2, k = tid & 3; float xk[4];
              const float* Ab = A + (16 * ib) * LS + 16 * ib + k;
#pragma unroll
              for (int i = 0; i < 4; ++i) xk[i] = XS[(16 * ib + 4 * i + k) * XL + c];
              float av[16][4];
#pragma unroll
              for (int r = 1; r < 16; ++r)
#pragma unroll
                  for (int j4 = 0; j4 <= ((r - 1) >> 2); ++j4) av[r][j4] = Ab[r * LS + 4 * j4];
              __builtin_amdgcn_sched_barrier(0);
#pragma unroll
              for (int r = 1; r < 16; ++r) { float part = 0.f;
#pragma unroll
                  for (int j4 = 0; j4 <= ((r - 1) >> 2); ++j4) part += av[r][j4] * xk[j4];
                  const float tot = quad_sum(part);
                  if (k == (r & 3)) xk[r >> 2] -= tot; }
#pragma unroll
              for (int i = 0; i < 4; ++i) XS[(16 * ib + 4 * i + k) * XL + c] = xk[i]; }
          LBAR();
      }
      bf16_t* ST2 = (bf16_t*)Q;
      { float xv[16];
#pragma unroll
        for (int i = 0; i < 16; ++i) { const int idx = tid + 512 * i, r = idx >> 7, c = idx & 127; xv[i] = XS[r * XL + c]; }
        __builtin_amdgcn_sched_barrier(0);
#pragma unroll
        for (int i = 0; i < 16; ++i) { const int r = (tid >> 7) + 4 * i, cc = tid & 63; const bf16_t v = (bf16_t)f2bf(xv[i]);
            if ((F.wave & 1) == 0) ST2[cfrag_off(r, cc)] = v; else ST2[4096 + frag_off(r, cc)] = v; } }
      LBAR();
      { const u32x4* sg = (const u32x4*)ST2; GU[tid] = sg[tid]; GW[tid] = sg[512 + tid]; }
    }
    LBAR();
}

__device__ __forceinline__ void ret_par_unit(Frame& F, int l, int b, int n, int h, int ul) {
    float* Q = F.ldsf; float* Kx = Q + 64 * LS; float* V = Kx + 64 * LS; float* gp = V + 64 * LS;
    unsigned char* RAW = (unsigned char*)F.ldsf + 53248;
    bf16_t* STG = (bf16_t*)((unsigned char*)F.ldsf + 80896);
    int tid = F.tid; asm volatile("" : "+v"(tid));
    const bf16_t* hin = ((bf16_t*)(F.ws + WS_BIG)) + (size_t)b * SEQL * DINP;
    const int* pos = (const int*)(const GAS int*)F.ap->in[2] + (size_t)b * SEQL + n * 64;
    unsigned char* SCRB = (unsigned char*)(F.ws + WS_XB);
    u32x4* GSC = (u32x4*)(SCRB + SC_RSC) + (size_t)ul * 512; u32x4* GQX = (u32x4*)(SCRB + SC_RQX) + (size_t)ul * 512;
    u32x4* GKT = (u32x4*)(SCRB + SC_RKT) + (size_t)ul * 512; u32x4* GVT = (u32x4*)(SCRB + SC_RVT) + (size_t)ul * 512;
    const float lg = (h == 0) ? -0.031748698314580f : (h == 1) ? -0.015748356968139f : (h == 2) ? -0.007843177461025f : -0.003913899321136f;
    if (tid < 65) gp[tid] = __expf((float)tid * lg);
    int posv[4];
#pragma unroll
    for (int k = 0; k < 4; ++k) posv[k] = pos[(tid >> 5) + 16 * k];
    { u32x4 r[3];
#pragma unroll
      for (int i = 0; i < 3; ++i) { const int p = tid + 512 * i, tsr = p >> 9, rem = p & 511, row = rem >> 3, ch = rem & 7;
          r[i] = *(const u32x4*)(hin + (size_t)(n * 64 + row) * DINP + tsr * 256 + h * 64 + ch * 8); }
#pragma unroll
      for (int i = 0; i < 3; ++i) { const int p = tid + 512 * i, tsr = p >> 9, rem = p & 511, row = rem >> 3, ch = rem & 7; *(u32x4*)(RAW + (tsr * 64 + row) * RP + ch * 16) = r[i]; } }
    LBAR();
    { bf16_t xa[8], xb2[8], vr[8];
      const int i = tid & 31;
#pragma unroll
      for (int it = 0; it < 8; ++it) { const int tsr = it >> 2, t = (tid >> 5) + 16 * (it & 3); const unsigned char* rb = RAW + (tsr * 64 + t) * RP; xa[it] = *(const bf16_t*)(rb + i * 2); xb2[it] = *(const bf16_t*)(rb + (i + 32) * 2); }
#pragma unroll
      for (int it = 0; it < 8; ++it) { const int idx = tid + 512 * it, t = idx >> 6, d = idx & 63; vr[it] = *(const bf16_t*)(RAW + (128 + t) * RP + d * 2); }
      __builtin_amdgcn_sched_barrier(0);
      const double invf = INVF_REV[i];
#pragma unroll
      for (int it = 0; it < 8; ++it) { const int tsr = it >> 2, t = (tid >> 5) + 16 * (it & 3);
          const float x1 = bf2f(xa[it]), x2 = bf2f(xb2[it]);
          const double rev = (double)posv[it & 3] * invf; const float fr = (float)(rev - __builtin_rint(rev));
          const float cs = __builtin_amdgcn_cosf(fr), sn = __builtin_amdgcn_sinf(fr); const float sc = tsr ? 1.0f : 0.125f;
          float* dst = F.ldsf + tsr * 64 * LS + t * LS; dst[i] = (x1 * cs - x2 * sn) * sc; dst[i + 32] = (x2 * cs + x1 * sn) * sc; }
#pragma unroll
      for (int it = 0; it < 8; ++it) { const int idx = tid + 512 * it, t = idx >> 6, d = idx & 63; V[t * LS + d] = bf2f(vr[it]); } }
    LBAR();
    { const int mt = F.wave >> 1, l15 = F.lane & 15, q = F.lane >> 4;
#pragma unroll
      for (int t2 = 0; t2 < 2; ++t2) { const int nt = 2 * (F.wave & 1) + t2; const int j = 16 * nt + l15; const f32x4 sc = tile_xyT(Q, Kx, mt, nt, F.lane);
#pragma unroll
          for (int jj = 0; jj < 4; ++jj) { const int i = 16 * mt + 4 * q + jj; const int dd = i > j ? i - j : j - i; STG[frag_off(i, j)] = (bf16_t)f2bf(sc[jj] * gp[dd]); } } }
    { float fv[24], fs[24];
#pragma unroll
      for (int i = 0; i < 24; ++i) { const int which = i >> 3, rem = tid + 512 * (i & 7), cc = rem >> 6, r = rem & 63;
          fs[i] = (which == 0) ? gp[cc + 1] : (which == 1) ? gp[63 - cc] : 1.0f; fv[i] = F.ldsf[which * 64 * LS + cc * LS + r]; }
      __builtin_amdgcn_sched_barrier(0);
#pragma unroll
      for (int i = 0; i < 24; ++i) fv[i] *= fs[i];
#pragma unroll
      for (int i = 0; i < 24; ++i) { const int which = i >> 3, rem = tid + 512 * (i & 7), cc = rem >> 6, r = rem & 63;     const bf16_t v = (bf16_t)f2bf(fv[i]);
          if (which == 0) STG[4096 + frag_off(cc, r)] = v; else if (which == 1) STG[8192 + frag_off(r, cc)] = v; else STG[12288 + bfrag_off(cc, r)] = v; } }
    LBAR();
    { const u32x4* sg = (const u32x4*)STG; GSC[tid] = sg[tid]; GQX[tid] = sg[512 + tid]; GKT[tid] = sg[1024 + tid]; GVT[tid] = sg[1536 + tid]; }
    LBAR();
}

__device__ __forceinline__ void lru_par_unit(Frame& F, int l, int b, int n, int g) {
    float* XC = F.ldsf; float* WA = XC + 64 * LS; float* WX = WA + 64 * LS; float* AA = WX + 64 * LS; float* BB = AA + 4096;
    int tid = F.tid; asm volatile("" : "+v"(tid));
    const bf16_t* hin = ((bf16_t*)(F.ws + WS_BIG)) + (size_t)b * SEQL * DINP;
    const float* wa = ((const float*)(const GAS float*)F.ap->in[12]) + (size_t)(l * 6 + g) * 4096; const float* wx = ((const float*)(const GAS float*)F.ap->in[14]) + (size_t)(l * 6 + g) * 4096;
    const float* cw = ((const float*)(const GAS float*)F.ap->in[10]) + (size_t)l * 4 * 384; const float* cb = ((const float*)(const GAS float*)F.ap->in[11]) + (size_t)l * 384;
    const int cch_ = g * 64 + (tid & 63); const float lw0 = cw[cch_], lw1 = cw[384 + cch_], lw2 = cw[768 + cch_], lw3 = cw[1152 + cch_], lcb = cb[cch_];
    float pba[2], pbx[2], plam[2];
#pragma unroll
    for (int t2 = 0; t2 < 2; ++t2) { const int ch = g * 64 + 32 * (F.wave & 1) + 16 * t2 + (F.lane & 15);
        pba[t2] = ((const float*)(const GAS float*)F.ap->in[13])[l * 384 + ch]; pbx[t2] = ((const float*)(const GAS float*)F.ap->in[15])[l * 384 + ch]; plam[t2] = ((const float*)(const GAS float*)F.ap->in[16])[l * 384 + ch]; }
    unsigned char* RAWX = (unsigned char*)F.ldsf + 84992;
    unsigned char* RAWG = RAWX + 67 * RP;
    { f32x4 wv[4]; u32x4 r[3];
#pragma unroll
      for (int i = 0; i < 2; ++i) { wv[i] = ((const f32x4*)wa)[tid + 512 * i]; wv[2 + i] = ((const f32x4*)wx)[tid + 512 * i]; }
#pragma unroll
      for (int i = 0; i < 3; ++i) { const int p = tid + 512 * i; r[i] = (u32x4){0u, 0u, 0u, 0u};
          if (p < 536) { const int row = p >> 3, ch = p & 7, tr = n * 64 - 3 + row; if (tr >= 0) r[i] = *(const u32x4*)(hin + (size_t)tr * DINP + C_LX + g * 64 + ch * 8); }
          else if (p < 1048) { const int q = p - 536, row = q >> 3, ch = q & 7; r[i] = *(const u32x4*)(hin + (size_t)(n * 64 + row) * DINP + C_LG + g * 64 + ch * 8); } }
#pragma unroll
      for (int i = 0; i < 2; ++i) { const int e0 = 4 * (tid + 512 * i), ii = e0 >> 6, j0 = e0 & 63;
#pragma unroll
          for (int k = 0; k < 4; ++k) { WA[(j0 + k) * LS + ii] = wv[i][k]; WX[(j0 + k) * LS + ii] = wv[2 + i][k]; } }
#pragma unroll
      for (int i = 0; i < 3; ++i) { const int p = tid + 512 * i;
          if (p < 536) *(u32x4*)(RAWX + (p >> 3) * RP + (p & 7) * 16) = r[i];
          else if (p < 1048) { const int q = p - 536; *(u32x4*)(RAWG + (q >> 3) * RP + (q & 7) * 16) = r[i]; } } }
    LBAR();
    { const int c = tid & 63; const float w0 = lw0, w1 = lw1, w2 = lw2, w3 = lw3, cbv = lcb;
      const unsigned char* rb = RAWX + c * 2; bf16_t xr[8][4];
#pragma unroll
      for (int i = 0; i < 8; ++i)
#pragma unroll
          for (int kk = 0; kk < 4; ++kk) xr[i][kk] = *(const bf16_t*)(rb + ((tid >> 6) + 8 * i + kk) * RP);
      __builtin_amdgcn_sched_barrier(0);
#pragma unroll
      for (int i = 0; i < 8; ++i) { const int t = (tid >> 6) + 8 * i;
          XC[t * LS + c] = cbv + ((w0 * bf2f(xr[i][0]) + w1 * bf2f(xr[i][1])) + (w2 * bf2f(xr[i][2]) + w3 * bf2f(xr[i][3]))); } }
    LBAR();
    { const int mt = F.wave >> 1, l15 = F.lane & 15, q = F.lane >> 4;
#pragma unroll
      for (int t2 = 0; t2 < 2; ++t2) { const int nt = 2 * (F.wave & 1) + t2; const int j = 16 * nt + l15, ch = g * 64 + j;
          const f32x4 accA = tile_xyT(XC, WA, mt, nt, F.lane), accX = tile_xyT(XC, WX, mt, nt, F.lane);
          const float ba = pba[t2], bx = pbx[t2], lam = plam[t2];
          const float ls = (-lam > 20.f) ? lam : -log1p_pos(__expf(-lam));
#pragma unroll
          for (int jj = 0; jj < 4; ++jj) { const int t = 16 * mt + 4 * q + jj; const float r = sigmoidf_(accA[jj] + ba), ig = sigmoidf_(accX[jj] + bx);
              const float la = 8.0f * r * ls; const float a = __expf(la); const float bc = __builtin_amdgcn_sqrtf(fmaxf(one_minus_exp(2.0f * la), 0.f)) * (ig * XC[t * LS + j]);
              AA[t * 64 + j] = a; BB[t * 64 + j] = bc; } } }
    LBAR();
    { const int w = tid >> 6, c = tid & 63; float hl[8], al[8]; float hcur = 0.f, ac = 1.f;
#pragma unroll
      for (int k = 0; k < 8; ++k) { hl[k] = BB[(8 * w + k) * 64 + c]; al[k] = AA[(8 * w + k) * 64 + c]; }
#pragma unroll
      for (int k = 0; k < 8; ++k) { hcur = al[k] * hcur + hl[k]; ac *= al[k]; hl[k] = hcur; al[k] = ac; }
      float* SEG = (float*)(RAWX);
      SEG[(w * 2) * 64 + c] = hcur; SEG[(w * 2 + 1) * 64 + c] = ac;
      LBAR();
      float ch_ = 0.f, ca_ = 1.f;
#pragma unroll
      for (int j = 0; j < 7; ++j) if (j < w) { const float hj = SEG[(j * 2) * 64 + c], aj = SEG[(j * 2 + 1) * 64 + c]; ch_ = aj * ch_ + hj; ca_ *= aj; }
#pragma unroll
      for (int k = 0; k < 8; ++k) { BB[(8 * w + k) * 64 + c] = hl[k] + al[k] * ch_; AA[(8 * w + k) * 64 + c] = al[k] * ca_; }
      if (w == 7) { const size_t so = (size_t)(b * 128 + n) * 384 + g * 64 + c; ((float*)(((unsigned char*)(F.ws + WS_XB)) + SC_LSH))[so] = hl[7] + al[7] * ch_; ((float*)(((unsigned char*)(F.ws + WS_XB)) + SC_LSA))[so] = al[7] * ca_; } }
    LBAR();
    bf16_t* P2 = ((bf16_t*)(F.ws + WS_BIG)) + (size_t)b * SEQL * DINP + C_LG;
#pragma unroll 2
    for (int i = 0; i < 8; ++i) { const int idx = tid + 512 * i, t = idx >> 6, c = idx & 63, ch = g * 64 + c, tok = n * 64 + t;
        const float ge = gelu_tanh(bf2f(*(const bf16_t*)(RAWG + t * RP + c * 2)));
        ((bf16_t*)(F.ws + WS_O))[((size_t)b * SEQL + tok) * DM + O_L + ch] = (bf16_t)f2bf(BB[t * 64 + c] * ge);
        P2[(size_t)tok * DINP + ch] = (bf16_t)f2bf(AA[t * 64 + c] * ge); }
    LBAR();
}

#ifndef PMASK
#define PMASK 7
#endif
#define PSEL(b) ((PMASK & (b)) != 0)
__device__ __forceinline__ void p_mix_par(Frame& F, int l) {
    for (int u = F.bid; u < 16384; u += F.G) {
        if (u < 6144) { const int h = u % 6, n = (u / 6) & 127, b = u / 768; if (PSEL(1)) gdn_par_unit(F, l, b, n, h, u); }
        else if (u < 10240) { const int v = u - 6144; const int h = v & 3, n = (v >> 2) & 127, b = v >> 9; if (PSEL(2)) ret_par_unit(F, l, b, n, h, v); }
        else { const int v = u - 10240; const int g = v % 6, n = (v / 6) & 127, b = v / 768; if (PSEL(4)) lru_par_unit(F, l, b, n, g); }
    }
}

#define MFMA16(a, b, c) __builtin_amdgcn_mfma_f32_16x16x32_bf16((a), (b), (c), 0, 0, 0)
template <bool GDN> __device__ __forceinline__ size_t seq_tile_base(int k) {
    if (GDN) return k == 0 ? SC_GW : k == 1 ? SC_GQ : k == 2 ? SC_GQK : k == 3 ? SC_GKT : SC_GU;
    return k == 0 ? SC_RQX : k == 1 ? SC_RSC : k == 2 ? SC_RKT : SC_RVT;
}
template <bool GDN>
__device__ __forceinline__ void seq_chain(Frame& F, int l, int b, int h) {
    constexpr int NT = GDN ? 5 : 4, NR = 2 * NT + 2;
    constexpr int EOFF = NT * 8192, SLOT = EOFF + 64, RING = 0, OUTB = 2 * SLOT, OUTSZ = 64 * 68 * 4;
    const int w = F.wave, lane = F.lane, q = lane >> 4, l15 = lane & 15;
    LAS unsigned char* const L = F.lds;
    const bf16_t* hin = ((bf16_t*)(F.ws + WS_BIG)) + (size_t)b * SEQL * DINP;
    const int zcol = (GDN ? C_GZ : C_RG) + h * 64;
    const size_t ustride = GDN ? 6 : 4, u0 = (size_t)(b * 128) * ustride + h;
    if (w >= 4) {
        const int lt = F.tid - 256, ch = lt & 7, r0 = lt >> 3;
        float gn[8];
#pragma unroll
        for (int k = 0; k < 8; ++k) gn[k] = GDN ? ((const float*)(const GAS float*)F.ap->in[20])[l * 64 + 8 * ch + k] : ((const float*)(const GAS float*)F.ap->in[9])[l * 256 + h * 64 + 8 * ch + k];
        bf16_t* const obase = ((bf16_t*)(F.ws + WS_O)) + (size_t)b * SEQL * DM + (GDN ? O_G : O_R) + h * 64 + 8 * ch;
        u32x4 R0[2 * NT], R1[2 * NT], R2[2 * NT], Z0[2], Z1[2], Z2[2]; float E0 = 0.f, E1 = 0.f, E2 = 0.f;
#define SEQ_LOAD(R, E, nn) do { if ((nn) < NCH) { const size_t un = u0 + (size_t)(nn) * ustride; \
            _Pragma("unroll") for (int k = 0; k < NT; ++k) { const u32x4* src = (const u32x4*)((unsigned char*)(F.ws + WS_XB) + seq_tile_base<GDN>(k)) + un * 512 + lt; R[2 * k] = src[0]; R[2 * k + 1] = src[256]; } \
            if (GDN) E = ((const float*)((unsigned char*)(F.ws + WS_XB) + SC_GVEC))[un * 256 + 63]; } } while (0)
#define SEQ_LOADZ(Z, nn) do { if ((nn) < NCH) { _Pragma("unroll") for (int i = 0; i < 2; ++i) Z[i] = *(const u32x4*)(hin + (size_t)((nn) * 64 + r0 + 32 * i) * DINP + zcol + ch * 8); } } while (0)
#define SEQ_STORE(R, E, nn) do { LAS unsigned char* sl = L + RING + ((nn) & 1) * SLOT; \
            _Pragma("unroll") for (int k = 0; k < NT; ++k) { *(LAS u32x4*)(sl + k * 8192 + lt * 16) = R[2 * k]; *(LAS u32x4*)(sl + k * 8192 + (lt + 256) * 16) = R[2 * k + 1]; } \
            if (GDN && lt == 0) *(LAS float*)(sl + EOFF) = E; } while (0)
#define SEQ_OUT(ZQ, nn) do { const LAS float* ob = (const LAS float*)(L + OUTB + ((nn) & 1) * OUTSZ); \
            _Pragma("unroll") for (int i = 0; i < 2; ++i) { const int rr = r0 + 32 * i; const f32x4 o0 = *(const LAS f32x4*)(ob + rr * 68 + 8 * ch), o1 = *(const LAS f32x4*)(ob + rr * 68 + 8 * ch + 4); \
                float s2 = ((o0[0] * o0[0] + o0[1] * o0[1]) + (o0[2] * o0[2] + o0[3] * o0[3])) + ((o1[0] * o1[0] + o1[1] * o1[1]) + (o1[2] * o1[2] + o1[3] * o1[3])); \
                float s1 = ((o0[0] + o0[1]) + (o0[2] + o0[3])) + ((o1[0] + o1[1]) + (o1[2] + o1[3])); \
                s2 += __builtin_bit_cast(float, __builtin_amdgcn_update_dpp(0, __builtin_bit_cast(int, s2), 0xB1, 0xF, 0xF, true)); s2 += __builtin_bit_cast(float, __builtin_amdgcn_update_dpp(0, __builtin_bit_cast(int, s2), 0x4E, 0xF, 0xF, true)); \
                s2 += __builtin_bit_cast(float, __builtin_amdgcn_update_dpp(0, __builtin_bit_cast(int, s2), 0x141, 0xF, 0xF, true)); \
                float mu = 0.f, rs; \
                if (GDN) { rs = __builtin_amdgcn_rsqf(s2 * (1.0f / 64.0f) + 1e-6f); } \
                else { s1 += __builtin_bit_cast(float, __builtin_amdgcn_update_dpp(0, __builtin_bit_cast(int, s1), 0xB1, 0xF, 0xF, true)); s1 += __builtin_bit_cast(float, __builtin_amdgcn_update_dpp(0, __builtin_bit_cast(int, s1), 0x4E, 0xF, 0xF, true)); \
                    s1 += __builtin_bit_cast(float, __builtin_amdgcn_update_dpp(0, __builtin_bit_cast(int, s1), 0x141, 0xF, 0xF, true)); \
                    mu = s1 * (1.0f / 64.0f); rs = __builtin_amdgcn_rsqf(fmaxf(s2 * (1.0f / 64.0f) - mu * mu, 0.f) + 1e-5f); } \
                float y[8]; \
                _Pragma("unroll") for (int k = 0; k < 4; ++k) { const unsigned zw = ZQ[i][k]; const float z0 = __builtin_bit_cast(float, zw << 16), z1 = __builtin_bit_cast(float, zw & 0xffff0000u); \
                    const float a0 = (k < 2 ? o0[2 * k] : o1[2 * k - 4]), a1 = (k < 2 ? o0[2 * k + 1] : o1[2 * k - 3]); \
                    y[2 * k] = (a0 - mu) * rs * gn[2 * k] * siluf_(z0); y[2 * k + 1] = (a1 - mu) * rs * gn[2 * k + 1] * siluf_(z1); } \
                u32x4 ov; ov.x = pk2(y[0], y[1]); ov.y = pk2(y[2], y[3]); ov.z = pk2(y[4], y[5]); ov.w = pk2(y[6], y[7]); \
                *(u32x4*)(obase + (size_t)((nn) * 64 + rr) * DM) = ov; } } while (0)
#define SEQ_LITER(R, E, ZQ, nn) do { if ((nn) <= NCH) { if ((nn) < NCH) { SEQ_STORE(R, E, nn); } SEQ_LOAD(R, E, (nn) + 3); LBAR(); \
            if ((nn) > 0) { SEQ_OUT(ZQ, (nn) - 1); } SEQ_LOADZ(ZQ, (nn) + 2); } } while (0)
        SEQ_LOAD(R0, E0, 0); SEQ_LOAD(R1, E1, 1); SEQ_LOAD(R2, E2, 2); SEQ_LOADZ(Z0, 0); SEQ_LOADZ(Z1, 1);
        for (int n = 0; n <= NCH; n += 3) { SEQ_LITER(R0, E0, Z2, n); SEQ_LITER(R1, E1, Z0, n + 1); SEQ_LITER(R2, E2, Z1, n + 2); }
#undef SEQ_LOAD
#undef SEQ_LOADZ
#undef SEQ_STORE
#undef SEQ_OUT
#undef SEQ_LITER
        return;
    }
    const float lgam = (h == 0) ? -0.031748698314580f : (h == 1) ? -0.015748356968139f : (h == 2) ? -0.007843177461025f : -0.003913899321136f;
    const float cd = __expf(64.0f * lgam);
    f32x4 S[4];
#pragma unroll
    for (int i = 0; i < 4; ++i) S[i] = (f32x4){0.f, 0.f, 0.f, 0.f};
    for (int n = 0; n <= NCH; ++n) {
        LBAR();
        if (n == NCH) break;
        LAS unsigned char* sl = L + RING + (n & 1) * SLOT;
        const LAS bf16x8* T0 = (const LAS bf16x8*)(sl) + lane; const LAS bf16x8* T1 = (const LAS bf16x8*)(sl + 8192) + lane;
        const LAS bf16x8* T2 = (const LAS bf16x8*)(sl + 2 * 8192) + lane; const LAS bf16x8* T3 = (const LAS bf16x8*)(sl + 3 * 8192) + lane;
        f32x4 Oa[4]; const f32x4 zero4 = {0.f, 0.f, 0.f, 0.f};
        bf16x8 Sb[2]; Sb[0] = pack8(S[0], S[1]); Sb[1] = pack8(S[2], S[3]);
        bf16x8 fa[8], fb[8];
#pragma unroll
        for (int f = 0; f < 8; ++f) { fa[f] = T0[f * 64]; fb[f] = T1[f * 64]; }
        if (GDN) {
            f32x4 P[4]; bf16x4 uf[4];
#pragma unroll
            for (int mt = 0; mt < 4; ++mt) uf[mt] = *(const LAS bf16x4*)(sl + 4 * 8192 + ((mt * 4 + w) * 64 + lane) * 8);
            const float egl = *(const LAS float*)(sl + EOFF);
            __builtin_amdgcn_sched_barrier(0);
#pragma unroll
            for (int mt = 0; mt < 4; ++mt) { P[mt] = MFMA16(fa[mt * 2], Sb[0], zero4); Oa[mt] = MFMA16(fb[mt * 2], Sb[0], zero4); }
#pragma unroll
            for (int mt = 0; mt < 4; ++mt) { P[mt] = MFMA16(fa[mt * 2 + 1], Sb[1], P[mt]); Oa[mt] = MFMA16(fb[mt * 2 + 1], Sb[1], Oa[mt]); }
            __builtin_amdgcn_sched_barrier(0);
#pragma unroll
            for (int f = 0; f < 8; ++f) { fa[f] = T2[f * 64]; fb[f] = T3[f * 64]; }
            f32x4 vn[4];
#pragma unroll
            for (int mt = 0; mt < 4; ++mt) { vn[mt] = unpack4(uf[mt]) - P[mt]; S[mt] = S[mt] * egl; }
            bf16x8 vnb[2]; vnb[0] = pack8(vn[0], vn[1]); vnb[1] = pack8(vn[2], vn[3]);
            __builtin_amdgcn_sched_barrier(0);
#pragma unroll
            for (int mt = 0; mt < 4; ++mt) { Oa[mt] = MFMA16(fa[mt * 2], vnb[0], Oa[mt]); S[mt] = MFMA16(fb[mt * 2], vnb[0], S[mt]); }
#pragma unroll
            for (int mt = 0; mt < 4; ++mt) { Oa[mt] = MFMA16(fa[mt * 2 + 1], vnb[1], Oa[mt]); S[mt] = MFMA16(fb[mt * 2 + 1], vnb[1], S[mt]); }
        } else {
            bf16x8 fc[8]; bf16x8 Vb[2]; Vb[0] = *(const LAS bf16x8*)(sl + 3 * 8192 + (w * 64 + lane) * 16); Vb[1] = *(const LAS bf16x8*)(sl + 3 * 8192 + ((4 + w) * 64 + lane) * 16);
#pragma unroll
            for (int f = 0; f < 8; ++f) fc[f] = T2[f * 64];
            __builtin_amdgcn_sched_barrier(0);
#pragma unroll
            for (int mt = 0; mt < 4; ++mt) { Oa[mt] = MFMA16(fa[mt * 2], Sb[0], zero4); S[mt] = S[mt] * cd; }
#pragma unroll
            for (int mt = 0; mt < 4; ++mt) { Oa[mt] = MFMA16(fa[mt * 2 + 1], Sb[1], Oa[mt]); S[mt] = MFMA16(fc[mt * 2], Vb[0], S[mt]); }
#pragma unroll
            for (int mt = 0; mt < 4; ++mt) { Oa[mt] = MFMA16(fb[mt * 2], Vb[0], Oa[mt]); S[mt] = MFMA16(fc[mt * 2 + 1], Vb[1], S[mt]); }
#pragma unroll
            for (int mt = 0; mt < 4; ++mt) Oa[mt] = MFMA16(fb[mt * 2 + 1], Vb[1], Oa[mt]);
        }
        LAS float* ob = (LAS float*)(L + OUTB + (n & 1) * OUTSZ) + w * 16 + l15;
#pragma unroll
        for (int mt = 0; mt < 4; ++mt)
#pragma unroll
            for (int j = 0; j < 4; ++j) ob[(16 * mt + 4 * q + j) * 68] = Oa[mt][j];
    }
}
__device__ __forceinline__ void lru_seq_item(Frame& F, int b, int g, int n) {
    const int c = F.lane, ch = g * 64 + c;
    const float* SH = (const float*)((unsigned char*)(F.ws + WS_XB) + SC_LSH) + (size_t)(b * 128) * 384 + ch; const float* SA = (const float*)((unsigned char*)(F.ws + WS_XB) + SC_LSA) + (size_t)(b * 128) * 384 + ch;
    const bf16_t* P2 = ((const bf16_t*)(F.ws + WS_BIG)) + ((size_t)b * SEQL + n * 64) * DINP + C_LG + ch;
    bf16_t* op = ((bf16_t*)(F.ws + WS_O)) + ((size_t)b * SEQL + n * 64) * DM + O_L + ch;
    float carry = 0.f;
    int k = 0;
    for (; k + 8 <= n; k += 8) { float sh[8], sa[8];
#pragma unroll
        for (int i = 0; i < 8; ++i) { sh[i] = SH[(size_t)(k + i) * 384]; sa[i] = SA[(size_t)(k + i) * 384]; }
#pragma unroll
        for (int i = 0; i < 8; ++i) carry = sh[i] + sa[i] * carry; }
    for (; k < n; ++k) carry = SH[(size_t)k * 384] + SA[(size_t)k * 384] * carry;
#pragma unroll 1
    for (int t0 = 0; t0 < 64; t0 += 16) { bf16_t r1[16], r2[16];
#pragma unroll
        for (int i = 0; i < 16; ++i) { r1[i] = op[(size_t)(t0 + i) * DM]; r2[i] = P2[(size_t)(t0 + i) * DINP]; }
        __builtin_amdgcn_sched_barrier(0);
#pragma unroll
        for (int i = 0; i < 16; ++i) op[(size_t)(t0 + i) * DM] = (bf16_t)f2bf(bf2f(r1[i]) + bf2f(r2[i]) * carry); }
}
__device__ __forceinline__ void p_mix_seq(Frame& F, int l) {
    const int ci = F.bid;
    if (ci < 48) { const int b = ci / 6, h = ci % 6; seq_chain<true>(F, l, b, h); }
    else if (ci < 80) { const int v = ci - 48; const int b = v >> 2, h = v & 3; seq_chain<false>(F, l, b, h); }
    else { const int nwv = (F.G - 80) * 8;
        for (int item = (ci - 80) * 8 + F.wave; item < 6144; item += nwv) { const int n = item & 127, v = item >> 7; const int b = v / 6, g = v % 6; lru_seq_item(F, b, g, n); } }
}

#ifndef GMASK
#define GMASK 63
#endif
#define GSEL(b) ((GMASK & (b)) != 0)
__global__ void __launch_bounds__(512, 2) fwd(Args args) {
    extern __shared__ __attribute__((aligned(16))) unsigned char lds[];
    const int lo = args.ph_lo, hi = args.ph_hi;
    if (hi - lo > 1) cg::this_grid().sync();
    const int wv0 = __builtin_amdgcn_readfirstlane((int)threadIdx.x >> 6);
#ifdef PROBE_CAT
    if (threadIdx.x == 0) { volatile unsigned long long* ptm = (volatile unsigned long long*)(lds + 143360); ptm[0] = __builtin_amdgcn_s_memrealtime(); ptm[1] = 0ull; }
#endif
    for (int ph = lo; ph < hi; ++ph) {
        if (ph > lo) {
            asm volatile("s_waitcnt vmcnt(0) lgkmcnt(0)\n\ts_barrier" ::: "memory");
            unsigned zb_ = 0u; asm volatile("" : "+s"(zb_));
            if (wv0 == 0 && __builtin_amdgcn_mbcnt_hi(~0u, __builtin_amdgcn_mbcnt_lo(~0u, zb_)) == 0u) {
                __builtin_amdgcn_fence(__ATOMIC_RELEASE, "agent"); asm volatile("s_waitcnt vmcnt(0) lgkmcnt(0)" ::: "memory");
                unsigned* cnt = (unsigned*)args.ws + 2048 + 64 * ph;
                __hip_atomic_fetch_add(cnt, 1u, __ATOMIC_RELAXED, __HIP_MEMORY_SCOPE_AGENT);
                while (__hip_atomic_load(cnt, __ATOMIC_RELAXED, __HIP_MEMORY_SCOPE_AGENT) < gridDim.x) __builtin_amdgcn_s_sleep(1);
                __builtin_amdgcn_fence(__ATOMIC_ACQUIRE, "agent"); asm volatile("s_waitcnt vmcnt(0) lgkmcnt(0)" ::: "memory");
            }
            asm volatile("s_waitcnt vmcnt(0) lgkmcnt(0)\n\ts_barrier" ::: "memory");
        }
        Frame F;
        { unsigned z_ = 0u; asm volatile("" : "+s"(z_));
          int t_ = (wv0 << 6) | (int)__builtin_amdgcn_mbcnt_hi(~0u, __builtin_amdgcn_mbcnt_lo(~0u, z_)); asm volatile("" : "+v"(t_));
          const CAS Args* ap_ = (const CAS Args*)__builtin_amdgcn_kernarg_segment_ptr(); asm volatile("" : "+s"(ap_)); F.ap = ap_; GAS unsigned char* w_ = (GAS unsigned char*)ap_->ws;
          F.lds = (LAS unsigned char*)lds; F.ldsf = (float*)lds; F.tid = t_; F.lane = t_ & 63; F.wave = __builtin_amdgcn_readfirstlane(t_ >> 6); int g_ = gridDim.x, b_ = blockIdx.x; asm volatile("" : "+s"(g_), "+s"(b_)); F.G = g_; F.bid = b_; F.ws = w_; }
#ifdef PROBE_CAT
        if (threadIdx.x == 0) { volatile unsigned long long* ptm = (volatile unsigned long long*)(lds + 143360); const unsigned long long tn = __builtin_amdgcn_s_memrealtime(); const int pp = ph - 1;
          const int s_ = (pp - 1) & 7; const bool hit = (pp > 0) && (PROBE_CAT >= 10 ? (s_ == PROBE_CAT - 10) : (PROBE_CAT == 3 ? s_ == 3 : PROBE_CAT == 4 ? s_ == 4 : (s_ != 3 && s_ != 4)));
          if (hit || (PROBE_CAT == 0 && pp == 0)) ptm[1] += tn - ptm[0];
          ptm[0] = tn; }
        if (ph == NPH) {
            __syncthreads();
            if (blockIdx.x == 0) { volatile unsigned long long* ptm = (volatile unsigned long long*)(lds + 143360); const float v = __builtin_amdgcn_sqrtf((float)ptm[1] * 0.01f * 1.024e-6f);
                for (int i = threadIdx.x; i < 65536; i += 512) ((float*)(GAS float*)args.out)[i] += v; }
            break; }
#endif
        if (ph == 0) { p_prologue(F); continue; }
        const int l = (ph - 1) / 8, s = (ph - 1) % 8;
        unsigned char* wt = (unsigned char*)(F.ws + WS_WT);
        bf16_t* const XBp = (bf16_t*)((unsigned char*)(F.ws + WS_XB)); bf16_t* const BIGp = (bf16_t*)(F.ws + WS_BIG); bf16_t* const OBp = (bf16_t*)(F.ws + WS_O);
        float* const Xp = (float*)(GAS float*)F.ap->out;
        if (s == 0 || s == 6) {
            { pg8::Gemm g{XBp, (const bf16_t*)(wt + (s == 0 ? WT_GU1 : WT_GU2))}; pg8::StaticOrder S; S.init(M, 2 * DFF, F.G, F.bid);
              pg8::EpiGated<0> E{BIGp, DFF}; pg8::gemm_phase<XBLD, DM, DM>(F.lds, F.tid, g, S, E); }
            if (s == 6) { pg8::Gemm g{XBp, (const bf16_t*)(wt + WT_PLE)}; pg8::StaticOrder S; S.init(M, 2048, F.G, F.bid);
              pg8::EpiGated<1> E{OBp, DM}; pg8::gemm_phase<XBLD, XBLD, XBLD, pg8::EpiGated<1>, 16>(F.lds, F.tid, g, S, E); }
            if (l == 0 && s == 6) p_convert_weights(F, 1, 1);
            if (l == 1 && s == 0) p_convert_weights(F, 1, 2);
        } else if (s == 1 || s == 7 || s == 5) {
            const int k = (s == 1) ? 0 : (s == 5) ? 1 : 2;
            const float* lg = (const float*)(const GAS float*)F.ap->in[k == 0 ? 3 : k == 1 ? 22 : 29] + l * DM; const float* lb = (const float*)(const GAS float*)F.ap->in[k == 0 ? 4 : k == 1 ? 23 : 30] + l * DM;
            const float* resid_ = (ph == 2) ? (const float*)(const GAS float*)F.ap->in[0] : (const float*)Xp;
            const float* pin_ = (s == 5) ? (const float*)(const GAS float*)F.ap->in[1] + (size_t)l * M * 256 : (const float*)nullptr;
            unsigned long long* xbuf_ = (unsigned long long*)(F.ws + WS_XBUF); unsigned* cnt_ = (unsigned*)(F.ws + WS_LNCNT) + (size_t)(l * 3 + k) * 256 * 64;
            pg8::StaticOrder S; S.init(M, DM, F.G, F.bid);
            if (s == 5) { pg8::EpiResidLN<false> E{resid_, Xp, XBp, (const bf16_t*)nullptr, pin_, 1.0f, lg, lb, xbuf_, cnt_, F.lds + 131072};
                pg8::Gemm g{OBp, (const bf16_t*)(wt + WT_OUT)}; pg8::gemm_phase<DM, DM, DM>(F.lds, F.tid, g, S, E); }
            else if (s == 1) { pg8::EpiResidLN<false> E{resid_, Xp, XBp, (const bf16_t*)nullptr, pin_, 0.5f, lg, lb, xbuf_, cnt_, F.lds + 131072};
                pg8::Gemm g{BIGp, (const bf16_t*)(wt + WT_D1)}; pg8::gemm_phase<DFF, DFF, DFF>(F.lds, F.tid, g, S, E); }
            else { pg8::EpiResidLN<true> E{resid_, Xp, XBp, (const bf16_t*)OBp, pin_, 0.5f, lg, lb, xbuf_, cnt_, F.lds + 131072};
                pg8::Gemm g{BIGp, (const bf16_t*)(wt + WT_D2)}; pg8::gemm_phase<DFF, DFF, DFF>(F.lds, F.tid, g, S, E); }
        } else if (s == 2) {
            pg8::Gemm g{XBp, (const bf16_t*)(wt + WT_IN)}; pg8::StaticOrder S; S.init(M, DINP, F.G, F.bid);
            pg8::EpiBf16 E{BIGp, DINP}; pg8::gemm_phase<XBLD, DM, DM>(F.lds, F.tid, g, S, E);
        } else if (s == 3) { p_mix_par(F, l);
        } else if (s == 4) {
#if defined(PROBE_CAT) && PROBE_CAT == 99
            unsigned long long c0_ = __builtin_amdgcn_s_memrealtime();
#endif
            p_mix_seq(F, l);
#if defined(PROBE_CAT) && PROBE_CAT == 99
            __syncthreads(); if (F.tid == 0) { volatile unsigned long long* ptm = (volatile unsigned long long*)(lds + 143360); ptm[1] += __builtin_amdgcn_s_memrealtime() - c0_; }
#endif
        }
    }
}

extern "C" void kernel_launch(void* const* d_in, const int* in_sizes, int n_in, void* d_out, int out_size, void* d_ws, size_t ws_size, hipStream_t stream) {
    static int grid = 0;
    if (grid == 0) {
        if (n_in != 31 || out_size != M * DM || ws_size < WS_END) { fprintf(stderr, "kernel_launch: unexpected shapes (n_in %d out %d ws %zu)\n", n_in, out_size, ws_size); grid = -1; return; }
        int dev = 0, cus = 0;
        hipGetDevice(&dev); hipDeviceGetAttribute(&cus, hipDeviceAttributeMultiprocessorCount, dev);
        if (hipFuncSetAttribute((const void*)fwd, hipFuncAttributeMaxDynamicSharedMemorySize, LDS_BYTES) != hipSuccess) { fprintf(stderr, "hipFuncSetAttribute failed\n"); grid = -1; return; }
        int per_cu = 0; hipOccupancyMaxActiveBlocksPerMultiprocessor(&per_cu, (const void*)fwd, 512, LDS_BYTES); (void)hipGetLastError();
        grid = 256;
        if (cus < 256) { fprintf(stderr, "kernel_launch: needs 256 CUs with one resident 512-thread workgroup each (cus %d, occupancy query %d)\n", cus, per_cu); grid = -1; }
    }
    if (grid < 0) return;
    if (hipMemsetAsync(d_ws, 0, CTL_BYTES, stream) != hipSuccess) { fprintf(stderr, "memset failed\n"); return; }
    Args a{};
    for (int i = 0; i < 31; ++i) a.in[i] = d_in[i];
    a.out = (float*)d_out; a.ws = (unsigned char*)d_ws;
#if ONE_LAUNCH
#ifdef PROBE_CAT
    a.ph_lo = 0; a.ph_hi = NPH + 1;
#else
    a.ph_lo = 0; a.ph_hi = NPH;
#endif
    void* kargs[] = {&a};
    hipError_t e = hipLaunchCooperativeKernel((const void*)fwd, dim3(grid), dim3(512), kargs, LDS_BYTES, stream);
    if (e != hipSuccess) fprintf(stderr, "cooperative launch failed: %s\n", hipGetErrorString(e));
#else
    for (int ph = 0; ph < NPH; ++ph) { a.ph_lo = ph; a.ph_hi = ph + 1; hipLaunchKernelGGL(fwd, dim3(grid), dim3(512), LDS_BYTES, stream, a); }
#endif
}
```

```cpp
#include <hip/hip_runtime.h>
#include <hip/hip_cooperative_groups.h>
#include <cstdio>
#include <cstdint>
namespace cg = cooperative_groups;

#ifndef ONE_LAUNCH
#define ONE_LAUNCH 1
#endif

#define LAS __attribute__((address_space(3)))
#define GAS __attribute__((address_space(1)))
#define CAS __attribute__((address_space(4)))
typedef unsigned short bf16_t;
typedef short bf16x8 __attribute__((ext_vector_type(8)));
typedef short bf16x4 __attribute__((ext_vector_type(4)));
typedef float f32x4 __attribute__((ext_vector_type(4)));
typedef float f32x2 __attribute__((ext_vector_type(2)));
typedef unsigned u32x4 __attribute__((ext_vector_type(4)));
typedef unsigned u32x2 __attribute__((ext_vector_type(2)));

constexpr int M = 65536, DM = 1024, DFF = 2816, DIN = 3340, DINP = 3584, SEQL = 8192, NCH = 128;
constexpr int XBLD = 1280;
constexpr float ALPHA = 1.41421356237309515f;
constexpr float LN_EPS = 1e-5f;
constexpr int C_RQ = 0, C_RK = 256, C_RV = 512, C_RG = 768, C_LX = 1024, C_LG = 1408, C_GQ = 1792, C_GK = 2176, C_GV = 2560, C_GZ = 2944, C_GA = 3328, C_GB = 3334;
constexpr int O_R = 0, O_L = 256, O_G = 640;

constexpr size_t MiB = 1u << 20;
constexpr size_t WS_WT = 1 * MiB;
constexpr size_t WT_GU1 = 0, WT_D1 = WT_GU1 + (size_t)5632 * 1024 * 2, WT_IN = WT_D1 + (size_t)1024 * 2816 * 2, WT_OUT = WT_IN + (size_t)3584 * 1024 * 2,
                 WT_GU2 = WT_OUT + (size_t)1024 * 1024 * 2, WT_D2 = WT_GU2 + (size_t)5632 * 1024 * 2, WT_PLE = WT_D2 + (size_t)1024 * 2816 * 2, WT_LAYER = WT_PLE + (size_t)2048 * 1280 * 2;
static_assert(WT_LAYER <= 48 * MiB, "weights");
constexpr size_t WS_XB = 52 * MiB;
constexpr size_t WS_BIG = 432 * MiB;
constexpr size_t WS_O = 880 * MiB;
constexpr size_t WS_XBUF = 1008 * MiB;
constexpr size_t WS_END = 1010 * MiB;
constexpr size_t WS_LNCNT = 16384;
constexpr size_t CTL_BYTES = 512 * 1024;
constexpr size_t NUG = 6144, NUR = 4096;
constexpr size_t SC_GW = 0, SC_GQK = SC_GW + NUG * 8192, SC_GQ = SC_GQK + NUG * 8192, SC_GKT = SC_GQ + NUG * 8192, SC_GU = SC_GKT + NUG * 8192, SC_GVEC = SC_GU + NUG * 8192,
                 SC_RSC = SC_GVEC + NUG * 1024, SC_RQX = SC_RSC + NUR * 8192, SC_RKT = SC_RQX + NUR * 8192, SC_RVT = SC_RKT + NUR * 8192,
                 SC_LSH = SC_RVT + NUR * 8192, SC_LSA = SC_LSH + (size_t)8 * 128 * 384 * 4, SC_END = SC_LSA + (size_t)8 * 128 * 384 * 4;
static_assert(WS_XB + SC_END <= WS_BIG, "mixer scratch");

constexpr int LDS_BYTES = 147456;
constexpr int NPH = 17;

struct Args { const void* in[31]; float* out; unsigned char* ws; int ph_lo, ph_hi; };

__device__ __forceinline__ unsigned f2bf(float f) { unsigned u = __builtin_bit_cast(unsigned, f); return (u + 0x7fffu + ((u >> 16) & 1u)) >> 16; }
__device__ __forceinline__ unsigned pk2(float lo, float hi) { return f2bf(lo) | (f2bf(hi) << 16); }
__device__ __forceinline__ float bf2f(bf16_t u) { return __builtin_bit_cast(float, (unsigned)u << 16); }
__device__ __forceinline__ float sigmoidf_(float x) { return __builtin_amdgcn_rcpf(1.0f + __expf(-x)); }
__device__ __forceinline__ float siluf_(float x) { return x * __builtin_amdgcn_rcpf(1.0f + __expf(-x)); }
__device__ __forceinline__ float log1p_pos(float e) { const float z = e * __builtin_amdgcn_rcpf(2.0f + e), z2 = z * z; const float sr = 2.0f * z * (1.0f + z2 * (0.333333333f + z2 * (0.2f + z2 * (0.142857143f + z2 * 0.111111111f)))); return e < 0.25f ? sr : __logf(1.0f + e); }
__device__ __forceinline__ float one_minus_exp(float y) { const float sr = -y * (1.0f + y * (0.5f + y * (0.166666667f + y * (0.0416666667f + y * 0.00833333333f)))); return y > -0.1f ? sr : 1.0f - __expf(y); }
__device__ __forceinline__ float gelu_tanh(float x) { const float u = 0.7978845608028654f * (x + 0.044715f * x * x * x); const float e = __expf(2.0f * u); const float th = 1.0f - 2.0f * __builtin_amdgcn_rcpf(e + 1.0f); return 0.5f * x * (1.0f + th); }
__device__ __forceinline__ bf16x8 pack8(f32x4 a, f32x4 b) { u32x4 w; w.x = pk2(a.x, a.y); w.y = pk2(a.z, a.w); w.z = pk2(b.x, b.y); w.w = pk2(b.z, b.w); return __builtin_bit_cast(bf16x8, w); }
__device__ __forceinline__ f32x4 unpack4(bf16x4 v) { f32x4 r; r.x = bf2f((bf16_t)v.x); r.y = bf2f((bf16_t)v.y); r.z = bf2f((bf16_t)v.z); r.w = bf2f((bf16_t)v.w); return r; }
__device__ __forceinline__ float wave_sum(float v) {
#pragma unroll
    for (int o = 1; o < 64; o <<= 1) v += __shfl_xor(v, o);
    return v;
}
__device__ __forceinline__ float lane_read(float v, int srclane) { return __builtin_bit_cast(float, __builtin_amdgcn_ds_bpermute(srclane << 2, __builtin_bit_cast(int, v))); }
__device__ __forceinline__ float quad_sum(float v) {
    v += __builtin_bit_cast(float, __builtin_amdgcn_update_dpp(0, __builtin_bit_cast(int, v), 0xB1, 0xF, 0xF, true));
    v += __builtin_bit_cast(float, __builtin_amdgcn_update_dpp(0, __builtin_bit_cast(int, v), 0x4E, 0xF, 0xF, true));
    return v;
}
__device__ __forceinline__ float row16_sum(float v) {
    v += __builtin_bit_cast(float, __builtin_amdgcn_update_dpp(0, __builtin_bit_cast(int, v), 0xB1, 0xF, 0xF, true));
    v += __builtin_bit_cast(float, __builtin_amdgcn_update_dpp(0, __builtin_bit_cast(int, v), 0x4E, 0xF, 0xF, true));
    v += __builtin_bit_cast(float, __builtin_amdgcn_update_dpp(0, __builtin_bit_cast(int, v), 0x141, 0xF, 0xF, true));
    v += __builtin_bit_cast(float, __builtin_amdgcn_update_dpp(0, __builtin_bit_cast(int, v), 0x140, 0xF, 0xF, true));
    return v;
}
__device__ __forceinline__ int frag_off(int row, int col) { const int mt = row >> 4, r = row & 15, ks = col >> 5, hi = (col >> 4) & 1, q = (col >> 2) & 3, lo = col & 3; return ((mt * 2 + ks) * 64 + q * 16 + r) * 8 + hi * 4 + lo; }
__device__ __forceinline__ int cfrag_off(int c, int e) { const int mt = c >> 4, q = (c >> 2) & 3, j = c & 3; return ((mt * 4 + (e >> 4)) * 64 + q * 16 + (e & 15)) * 4 + j; }
__device__ __forceinline__ int bfrag_off(int c, int e) { const int ks = c >> 5, hi = (c >> 4) & 1, q = (c >> 2) & 3, lo = c & 3; return ((ks * 4 + (e >> 4)) * 64 + q * 16 + (e & 15)) * 8 + hi * 4 + lo; }

__constant__ double INVF_REV[32] = {1.59154943091895346e-01, 1.19349370211248862e-01, 8.94994016088910133e-02, 6.71150830052272551e-02, 5.03292121044870353e-02, 3.77415847174197711e-02, 2.83021958306233987e-02, 2.12236527647776604e-02, 1.59154943091895339e-02, 1.19349370211248862e-02, 8.94994016088910237e-03, 6.71150830052272534e-03, 5.03292121044870370e-03, 3.77415847174197719e-03, 2.83021958306233987e-03, 2.12236527647776622e-03, 1.59154943091895356e-03, 1.19349370211248849e-03, 8.94994016088910237e-04, 6.71150830052272599e-04, 5.03292121044870326e-04, 3.77415847174197741e-04, 2.83021958306233954e-04, 2.12236527647776605e-04, 1.59154943091895351e-04, 1.19349370211248862e-04, 8.94994016088910182e-05, 6.71150830052272545e-05, 5.03292121044870354e-05, 3.77415847174197768e-05, 2.83021958306233961e-05, 2.12236527647776592e-05};

namespace pg8 {
constexpr int BM = 256, BK = 64, HALF = 128, HTB = HALF * BK * 2, STAGE_BYTES = 8 * HTB, NXCD = 8, WGM = 8;
__device__ __forceinline__ int lds_byte(int r, int c) { const int st = (r >> 4) * 2 + (c >> 5), rr = r & 15, cc = c & 31, ob = rr * 64 + cc * 2; return st * 1024 + (ob ^ (((ob >> 9) & 1) << 5)); }
__device__ __forceinline__ void stage_rc(int b, int& R, int& C) { const int st = b / 1024, sb = b % 1024, swz = sb ^ (((sb >> 9) & 1) << 5); R = (st >> 1) * 16 + swz / 64; C = (st & 1) * 32 + (swz % 64) / 2; }
__device__ __forceinline__ int perm32(int rho) { const int n = rho >> 4, i = rho & 15; return 8 * (i >> 2) + 4 * n + (i & 3); }
struct Unit { int pm, pn; };
struct Gemm { const bf16_t* A; const bf16_t* Bt; };
struct StaticOrder {
    int nM, nN, nwg, G, c;
    __device__ void init(int M_, int N_, int G_, int c_) { nM = M_ / BM; nN = N_ / BM; nwg = nM * nN; G = G_; c = c_; }
    __device__ bool next(int i, Unit& u) const {
        const long L = (long)i * G + c; if (L >= nwg) return false;
        int wgid = (int)L; { const int q = nwg / NXCD, r = nwg % NXCD, xcd = wgid % NXCD, off = wgid / NXCD; wgid = (xcd < r ? xcd * (q + 1) : r * (q + 1) + (xcd - r) * q) + off; }
        const int nig = WGM * nN, gid = wgid / nig, fm = gid * WGM, gsz = (nM - fm) < WGM ? (nM - fm) : WGM;
        u.pm = fm + ((wgid % nig) % gsz); u.pn = (wgid % nig) / gsz; return true;
    }
};
struct EpiBf16 {
    static constexpr bool PERM = true;
    bf16_t* O; int ldc;
    __device__ __forceinline__ void operator()(const f32x4 (&acc)[2][2][4][2], const Unit& u, int wr, int wc, int fr, int fq) const {
        const int row0 = u.pm * BM + wr * 64 + fr, col0 = u.pn * BM + wc * 32 + 8 * fq;
#pragma unroll
        for (int ai = 0; ai < 2; ++ai)
#pragma unroll
            for (int m = 0; m < 4; ++m) { bf16_t* rowp = O + (size_t)(row0 + ai * HALF + m * 16) * ldc + col0;
#pragma unroll
                for (int bj = 0; bj < 2; ++bj) { const f32x4 v0 = acc[ai][bj][m][0], v1 = acc[ai][bj][m][1];
                    u32x4 w; w.x = pk2(v0[0], v0[1]); w.y = pk2(v0[2], v0[3]); w.z = pk2(v1[0], v1[1]); w.w = pk2(v1[2], v1[3]);
                    *(u32x4*)(rowp + bj * HALF) = w; } }
    }
};
template <int ACT  > struct EpiGated {
    static constexpr bool PERM = true;
    bf16_t* O; int ldc;
    __device__ __forceinline__ void operator()(const f32x4 (&acc)[2][2][4][2], const Unit& u, int wr, int wc, int fr, int fq) const {
        const int row0 = u.pm * BM + wr * 64 + fr, col0 = u.pn * HALF + wc * 32 + 8 * fq;
#pragma unroll
        for (int ai = 0; ai < 2; ++ai)
#pragma unroll
            for (int m = 0; m < 4; ++m) { bf16_t* rowp = O + (size_t)(row0 + ai * HALF + m * 16) * ldc + col0;
                float h[8];
#pragma unroll
                for (int n = 0; n < 2; ++n)
#pragma unroll
                    for (int j = 0; j < 4; ++j) { const float g = acc[ai][0][m][n][j], up = acc[ai][1][m][n][j]; const float s = __builtin_amdgcn_rcpf(1.0f + __expf(-g)); h[n * 4 + j] = (ACT == 0 ? g * s : s) * up; }
                u32x4 w; w.x = pk2(h[0], h[1]); w.y = pk2(h[2], h[3]); w.z = pk2(h[4], h[5]); w.w = pk2(h[6], h[7]);
                *(u32x4*)rowp = w; }
    }
};
struct EpiResid {
    static constexpr bool PERM = false;
    const float* resid; float* out; const bf16_t* ple; float s;
    __device__ __forceinline__ void operator()(const f32x4 (&acc)[2][2][4][2], const Unit& u, int wr, int wc, int fr, int fq) const {
        const int col0 = u.pn * BM + wc * 32 + 4 * fq;
#pragma unroll
        for (int ai = 0; ai < 2; ++ai)
#pragma unroll
            for (int m = 0; m < 4; ++m) { const size_t off = (size_t)(u.pm * BM + ai * HALF + wr * 64 + m * 16 + fr) * DM + col0;
#pragma unroll
                for (int bj = 0; bj < 2; ++bj)
#pragma unroll
                    for (int n = 0; n < 2; ++n) { const size_t o2 = off + bj * HALF + n * 16; const f32x4 x = *(const f32x4*)(resid + o2); f32x4 o = x * ALPHA + acc[ai][bj][m][n] * s;
                        if (ple) { const bf16x4 pv = *(const bf16x4*)(ple + o2); o = o + unpack4(pv); }
                        *(f32x4*)(out + o2) = o; } }
    }
};

template <bool HAS_PLE> struct EpiResidLN {
    static constexpr bool PERM = false;
    const float* resid; float* out; bf16_t* xb; const bf16_t* ple; const float* pin; float s;
    const float* g; const float* b; unsigned long long* xbuf; unsigned* cnt; LAS unsigned char* lds;
    __device__ __forceinline__ void operator()(f32x4 (&acc)[2][2][4][2], const Unit& u, int wr, int wc, int fr0, int fq0) const {
        typedef float f32x2v __attribute__((ext_vector_type(2)));
        int fr = fr0, fq = fq0; asm volatile("" : "+v"(fr), "+v"(fq));
        LAS f32x2v* P = (LAS f32x2v*)lds;
        LAS f32x2v* S = (LAS f32x2v*)(lds + 8192);
        const int wid = wr * 4 + wc, lane = fq * 16 + fr;
        const int col0 = u.pn * BM + wc * 32 + 4 * fq;
#pragma unroll
        for (int ai = 0; ai < 2; ++ai)
#pragma unroll
            for (int m = 0; m < 4; ++m) { f32x4 rv[2][2]; bf16x4 pv[2][2]; const size_t off = (size_t)(u.pm * BM + ai * HALF + wr * 64 + m * 16 + fr) * DM + col0;
#pragma unroll
                for (int bj = 0; bj < 2; ++bj)
#pragma unroll
                    for (int n = 0; n < 2; ++n) { const size_t o2 = off + bj * HALF + n * 16; rv[bj][n] = *(const f32x4*)(resid + o2); if (HAS_PLE) pv[bj][n] = *(const bf16x4*)(ple + o2); }
#pragma unroll
                for (int bj = 0; bj < 2; ++bj)
#pragma unroll
                    for (int n = 0; n < 2; ++n) { f32x4 o = rv[bj][n] * ALPHA + acc[ai][bj][m][n] * s; if (HAS_PLE) o = o + unpack4(pv[bj][n]); acc[ai][bj][m][n] = o; }
                asm volatile("" : "+v"(acc[ai][0][m][0]), "+v"(acc[ai][0][m][1]), "+v"(acc[ai][1][m][0]), "+v"(acc[ai][1][m][1]));
                asm volatile("" ::: "memory"); }
#pragma unroll
        for (int ai = 0; ai < 2; ++ai)
#pragma unroll
            for (int m = 0; m < 4; ++m) { float sm = 0.f;
#pragma unroll
                for (int bj = 0; bj < 2; ++bj)
#pragma unroll
                    for (int n = 0; n < 2; ++n) { const f32x4 x = acc[ai][bj][m][n]; sm += (x[0] + x[1]) + (x[2] + x[3]); }
                sm += lane_read(sm, lane ^ 16); sm += lane_read(sm, lane ^ 32);
                const float mw = sm * (1.0f / 64.0f); float qq = 0.f;
#pragma unroll
                for (int bj = 0; bj < 2; ++bj)
#pragma unroll
                    for (int n = 0; n < 2; ++n) { const f32x4 d = acc[ai][bj][m][n] - mw; qq += (d[0] * d[0] + d[1] * d[1]) + (d[2] * d[2] + d[3] * d[3]); }
                qq += lane_read(qq, lane ^ 16); qq += lane_read(qq, lane ^ 32);
                if (fq == 0) P[(ai * HALF + wr * 64 + m * 16 + fr) * 4 + wc] = (f32x2v){mw, qq}; }
        asm volatile("s_waitcnt lgkmcnt(0)\n\ts_barrier" ::: "memory");
        const int row = wid * 32 + (lane & 31);
        if (lane < 32) { const f32x2v a = P[row * 4 + 0], bb = P[row * 4 + 1], c = P[row * 4 + 2], d = P[row * 4 + 3];
            const float mt = (a.x + bb.x + c.x + d.x) * 0.25f; const float da = a.x - mt, db = bb.x - mt, dc = c.x - mt, dd = d.x - mt;
            const float m2 = (a.y + bb.y) + (c.y + d.y) + 64.0f * ((da * da + db * db) + (dc * dc + dd * dd));
            unsigned long long* slot = xbuf + ((size_t)(u.pm * BM + row) * 4 + u.pn);
            __hip_atomic_store(slot, ((unsigned long long)__builtin_bit_cast(unsigned, m2) << 32) | __builtin_bit_cast(unsigned, mt), __ATOMIC_RELAXED, __HIP_MEMORY_SCOPE_AGENT); }
        asm volatile("s_waitcnt vmcnt(0)" ::: "memory");
        if (lane == 0) __hip_atomic_fetch_add(cnt + 64 * u.pm, 1u, __ATOMIC_RELAXED, __HIP_MEMORY_SCOPE_AGENT);
        f32x4 g4v[2][2], b4v[2][2];
#pragma unroll
        for (int bj = 0; bj < 2; ++bj)
#pragma unroll
            for (int n = 0; n < 2; ++n) { const int col = col0 + bj * HALF + n * 16; g4v[bj][n] = *(const f32x4*)(g + col); b4v[bj][n] = *(const f32x4*)(b + col); }
        if (wid == 0) { while ((unsigned)__builtin_amdgcn_readfirstlane(__hip_atomic_load(cnt + 64 * u.pm, __ATOMIC_RELAXED, __HIP_MEMORY_SCOPE_AGENT)) < 32u) __builtin_amdgcn_s_sleep(1);
            __builtin_amdgcn_fence(__ATOMIC_ACQUIRE, "agent"); }
        asm volatile("s_waitcnt vmcnt(0) lgkmcnt(0)\n\ts_barrier" ::: "memory");
        if (lane < 32) { const unsigned long long* slot = xbuf + (size_t)(u.pm * BM + row) * 4; float mt[4], m2[4]; float ms = 0.f;
            unsigned long long w4[4];
#pragma unroll
            for (int t = 0; t < 4; ++t) w4[t] = __hip_atomic_load(slot + t, __ATOMIC_RELAXED, __HIP_MEMORY_SCOPE_AGENT);
            __builtin_amdgcn_sched_barrier(0);
#pragma unroll
            for (int t = 0; t < 4; ++t) { mt[t] = __builtin_bit_cast(float, (unsigned)w4[t]); m2[t] = __builtin_bit_cast(float, (unsigned)(w4[t] >> 32)); ms += mt[t]; }
            const float mean = ms * 0.25f; float qv = 0.f;
#pragma unroll
            for (int t = 0; t < 4; ++t) { const float dm = mt[t] - mean; qv += m2[t] + 256.0f * dm * dm; }
            S[row] = (f32x2v){mean, __builtin_amdgcn_rsqf(qv * (1.0f / 1024.0f) + LN_EPS)}; }
        asm volatile("s_waitcnt vmcnt(0) lgkmcnt(0)\n\ts_barrier" ::: "memory");
#pragma unroll
        for (int bj = 0; bj < 2; ++bj)
#pragma unroll
            for (int n = 0; n < 2; ++n) { const int col = col0 + bj * HALF + n * 16; const f32x4 g4 = g4v[bj][n], b4 = b4v[bj][n];
#pragma unroll
                for (int ai = 0; ai < 2; ++ai)
#pragma unroll
                    for (int m = 0; m < 4; ++m) { const int r = ai * HALF + wr * 64 + m * 16 + fr; const f32x2v sr = S[r]; const size_t grow = (size_t)(u.pm * BM + r);
                        const f32x4 y = (acc[ai][bj][m][n] - sr.x) * sr.y * g4 + b4;
                        *(f32x4*)(out + grow * DM + col) = y; u32x2 w; w.x = pk2(y[0], y[1]); w.y = pk2(y[2], y[3]); *(u32x2*)(xb + grow * XBLD + col) = w; } }
        if (pin) { f32x4 pv8[8];
#pragma unroll
            for (int i = 0; i < 8; ++i) { const int idx = wid * 64 + lane + 512 * i, rr = idx >> 4, c4 = idx & 15; pv8[i] = *(const f32x4*)(pin + (size_t)(u.pm * BM + rr) * 256 + 64 * u.pn + 4 * c4); }
#pragma unroll
            for (int i = 0; i < 8; ++i) { const int idx = wid * 64 + lane + 512 * i, rr = idx >> 4, c4 = idx & 15; const f32x4 pv = pv8[i];
                u32x2 w; w.x = pk2(pv[0], pv[1]); w.y = pk2(pv[2], pv[3]); *(u32x2*)(xb + (size_t)(u.pm * BM + rr) * XBLD + 1024 + 64 * u.pn + 4 * c4) = w; } }
    }
};

template <int LDA, int LDB, int KK, class Epi, int SPLIT_T = 0>
__device__ __forceinline__ void gemm_phase(LAS unsigned char* lds, const int tid, const Gemm g, const StaticOrder& S, const Epi& E) {
    const int  wid = __builtin_amdgcn_readfirstlane(tid >> 6), lane = tid & 63, wr = wid >> 2, wc = wid & 3, fr = lane & 15, fq = lane >> 4;
    constexpr int nt = KK / BK;
    unsigned voffA[2], voffB[2];
#pragma unroll
    for (int i = 0; i < 2; ++i) { int R, C; stage_rc(tid * 16 + i * 8192, R, C); const int Rb = Epi::PERM ? ((R & ~31) + perm32(R & 31)) : R;
        voffA[i] = (unsigned)(R * LDA + C) * 2u; voffB[i] = (unsigned)(Rb * LDB + C) * 2u; }
    constexpr size_t kstep = (size_t)(BK * 2);
    constexpr size_t hstepA = (size_t)HALF * LDA * 2, hstepB = (size_t)HALF * LDB * 2;
    constexpr size_t tstepA = 2 * hstepA, tstepB = 2 * hstepB;
    const unsigned ldsw = (unsigned)wid * 1024u;
    const int aoff = lds_byte(wr * 64 + fr, fq * 8), boff = lds_byte(wc * 32 + fr, fq * 8);
#define PG8_SA(b, h) (((b) * 2 + (h)) * HTB)
#define PG8_SB(b, h) ((4 + (b) * 2 + (h)) * HTB)
#define PG8_STAGE(bufoff, gbase, voff) do { _Pragma("unroll") for (int _i = 0; _i < 2; ++_i) \
        __builtin_amdgcn_global_load_lds((const unsigned*)((const char*)(gbase) + (voff)[_i]), (LAS unsigned*)(lds + (bufoff) + ldsw + _i * 8192), 16, 0, 0); } while (0)
#define PG8_LDA(dst, b, h) do { _Pragma("unroll") for (int m = 0; m < 4; ++m) _Pragma("unroll") for (int k = 0; k < 2; ++k) dst[m][k] = *(const LAS bf16x8*)(lds + PG8_SA(b, h) + aoff + m * 2048 + k * 1024); } while (0)
#define PG8_LDB(dst, b, h) do { _Pragma("unroll") for (int n = 0; n < 2; ++n) _Pragma("unroll") for (int k = 0; k < 2; ++k) dst[n][k] = *(const LAS bf16x8*)(lds + PG8_SB(b, h) + boff + n * 2048 + k * 1024); } while (0)
#define PG8_MMA(ai, bj, At, Bt) do { __builtin_amdgcn_s_setprio(1); _Pragma("unroll") for (int m = 0; m < 4; ++m) _Pragma("unroll") for (int n = 0; n < 2; ++n) _Pragma("unroll") for (int k = 0; k < 2; ++k) \
        acc[ai][bj][m][n] = __builtin_amdgcn_mfma_f32_16x16x32_bf16(Bt[n][k], At[m][k], acc[ai][bj][m][n], 0, 0, 0); __builtin_amdgcn_s_setprio(0); } while (0)
#define PG8_WAIT_V(n) asm volatile("s_waitcnt vmcnt(" #n ")" ::: "memory")
#define PG8_WAIT_L(n) asm volatile("s_waitcnt lgkmcnt(" #n ")" ::: "memory")
#define PG8_BAR __builtin_amdgcn_s_barrier()
#define PG8_SCHED __builtin_amdgcn_sched_barrier(0)
    Unit cur, nxt; int ui = 0;
    if (!S.next(0, cur)) return;
    f32x4 acc[2][2][4][2];
#pragma unroll
    for (int a = 0; a < 2; ++a)
#pragma unroll
        for (int b = 0; b < 2; ++b)
#pragma unroll
            for (int m = 0; m < 4; ++m)
#pragma unroll
                for (int n = 0; n < 2; ++n) acc[a][b][m][n] = (f32x4){0.f, 0.f, 0.f, 0.f};
    bf16x8 At[4][2], B0[2][2], B1[2][2];
    const char* cA = (const char*)g.A + (size_t)cur.pm * tstepA; const char* cB = (const char*)g.Bt + (size_t)cur.pn * tstepB;
    PG8_STAGE(PG8_SB(0, 0), cB, voffB); PG8_STAGE(PG8_SB(0, 1), cB + hstepB, voffB); PG8_STAGE(PG8_SA(0, 0), cA, voffA); PG8_STAGE(PG8_SA(0, 1), cA + hstepA, voffA);
    if (wr == 1) PG8_BAR;
    PG8_WAIT_V(2); PG8_BAR;
    PG8_STAGE(PG8_SB(1, 0), cB + kstep, voffB); PG8_STAGE(PG8_SA(1, 0), cA + kstep, voffA); PG8_STAGE(PG8_SB(1, 1), cB + hstepB + kstep, voffB);
    PG8_WAIT_V(6); PG8_BAR;
    for (;;) {
        const bool has_next = S.next(ui + 1, nxt);
        const char* nA = has_next ? (const char*)g.A + (size_t)nxt.pm * tstepA : cA; const char* nB = has_next ? (const char*)g.Bt + (size_t)nxt.pn * tstepB : cB;
        for (int t = 0; t < nt; t += 2) {
            const bool last = (t == nt - 2);
            const char* a1 = cA + (size_t)(t + 1) * kstep;
            const char* a2 = last ? nA : cA + (size_t)(t + 2) * kstep; const char* b2 = last ? nB : cB + (size_t)(t + 2) * kstep;
            const char* a3 = a2 + kstep; const char* b3 = b2 + kstep;
            PG8_LDB(B0, 0, 0); PG8_LDB(B1, 0, 1); PG8_SCHED; PG8_LDA(At, 0, 0); PG8_STAGE(PG8_SA(1, 1), a1 + hstepA, voffA);
            PG8_WAIT_V(8); PG8_WAIT_L(0); PG8_BAR; if (SPLIT_T == 0 || t < SPLIT_T) PG8_MMA(0, 0, At, B0); if (SPLIT_T == 0 || t >= SPLIT_T) PG8_MMA(0, 1, At, B1); PG8_BAR; PG8_SCHED;
            PG8_LDA(At, 0, 1); PG8_STAGE(PG8_SB(0, 0), b2, voffB); PG8_STAGE(PG8_SB(0, 1), b2 + hstepB, voffB); PG8_STAGE(PG8_SA(0, 0), a2, voffA);
            PG8_WAIT_V(8); PG8_WAIT_L(0); PG8_BAR; if (SPLIT_T == 0 || t < SPLIT_T) PG8_MMA(1, 0, At, B0); if (SPLIT_T == 0 || t >= SPLIT_T) PG8_MMA(1, 1, At, B1); PG8_BAR; PG8_SCHED;
            PG8_LDB(B0, 1, 0); PG8_LDB(B1, 1, 1); PG8_SCHED; PG8_LDA(At, 1, 0); PG8_STAGE(PG8_SA(0, 1), a2 + hstepA, voffA);
            PG8_WAIT_V(8); PG8_WAIT_L(0); PG8_BAR; if (SPLIT_T == 0 || t < SPLIT_T) PG8_MMA(0, 0, At, B0); if (SPLIT_T == 0 || t >= SPLIT_T) PG8_MMA(0, 1, At, B1); PG8_BAR; PG8_SCHED;
            PG8_LDA(At, 1, 1); PG8_STAGE(PG8_SB(1, 0), b3, voffB); PG8_STAGE(PG8_SB(1, 1), b3 + hstepB, voffB); PG8_STAGE(PG8_SA(1, 0), a3, voffA);
            PG8_WAIT_V(8); PG8_WAIT_L(0); PG8_BAR; if (SPLIT_T == 0 || t < SPLIT_T) PG8_MMA(1, 0, At, B0); if (SPLIT_T == 0 || t >= SPLIT_T) PG8_MMA(1, 1, At, B1); PG8_BAR; PG8_SCHED;
        }
        if (wr == 0) PG8_BAR;
        E(acc, cur, wr, wc, fr, fq);
        if (!has_next) break;
#pragma unroll
        for (int a = 0; a < 2; ++a)
#pragma unroll
            for (int b = 0; b < 2; ++b)
#pragma unroll
                for (int m = 0; m < 4; ++m)
#pragma unroll
                    for (int n = 0; n < 2; ++n) acc[a][b][m][n] = (f32x4){0.f, 0.f, 0.f, 0.f};
        cur = nxt; cA = nA; cB = nB; ++ui;
        if (wr == 1) PG8_BAR;
    }
    PG8_WAIT_V(0);
    PG8_BAR;
#undef PG8_SA
#undef PG8_SB
#undef PG8_STAGE
#undef PG8_LDA
#undef PG8_LDB
#undef PG8_MMA
#undef PG8_WAIT_V
#undef PG8_WAIT_L
#undef PG8_BAR
#undef PG8_SCHED
}
}

struct Frame {
    LAS unsigned char* lds; float* ldsf;
    int tid, lane, wave, G, bid; GAS unsigned char* ws; const CAS struct Args* ap;
};

__device__ __forceinline__ void conv_mat(const Frame& F, const float* W, int K, int N, int Ndst, bf16_t* dst, int ldd, int kofs, int mode) {
    const int gw = F.bid * 8 + F.wave, NGW = F.G * 8;
    const int nblk = Ndst / 8, kblk = K / 64, items = nblk * kblk;
    const int nl = F.lane >> 3, kc = F.lane & 7;
    for (int it = gw; it < items; it += NGW) {
        const int nb = it % nblk, kb = it / nblk; const int n = nb * 8 + nl, k0 = kb * 64 + kc * 8;
        const int nc = n < N ? n : N - 1;
        float v[8];
#pragma unroll
        for (int kk = 0; kk < 8; ++kk) v[kk] = W[(size_t)(k0 + kk) * N + nc];
        const float zf = n < N ? 1.0f : 0.0f;
        const int row = (mode == 0) ? n : ((n >> 7) * 256 + (n & 127) + (mode == 2 ? 128 : 0));
        u32x4 w; w.x = pk2(v[0] * zf, v[1] * zf); w.y = pk2(v[2] * zf, v[3] * zf); w.z = pk2(v[4] * zf, v[5] * zf); w.w = pk2(v[6] * zf, v[7] * zf);
        *(u32x4*)(dst + (size_t)row * ldd + kofs + k0) = w;
    }
}
__device__ __forceinline__ void p_convert_weights(Frame& F, int l, int parts) {
    const int gw = F.bid * 8 + F.wave, NGW = F.G * 8;
    unsigned char* wt = (unsigned char*)(F.ws + WS_WT);
    if (parts & 1) {
    conv_mat(F, ((const float*)(const GAS float*)F.ap->in[5]) + (size_t)l * DM * DFF, DM, DFF, DFF, (bf16_t*)(wt + WT_GU1), DM, 0, 1);
    conv_mat(F, ((const float*)(const GAS float*)F.ap->in[6]) + (size_t)l * DM * DFF, DM, DFF, DFF, (bf16_t*)(wt + WT_GU1), DM, 0, 2);
    conv_mat(F, ((const float*)(const GAS float*)F.ap->in[7]) + (size_t)l * DFF * DM, DFF, DM, DM, (bf16_t*)(wt + WT_D1), DFF, 0, 0);
    conv_mat(F, ((const float*)(const GAS float*)F.ap->in[8]) + (size_t)l * DM * DIN, DM, DIN, DINP, (bf16_t*)(wt + WT_IN), DM, 0, 0);
    conv_mat(F, ((const float*)(const GAS float*)F.ap->in[21]) + (size_t)l * DM * DM, DM, DM, DM, (bf16_t*)(wt + WT_OUT), DM, 0, 0);
    }
    if (parts & 2) {
    conv_mat(F, ((const float*)(const GAS float*)F.ap->in[24]) + (size_t)l * DM * DFF, DM, DFF, DFF, (bf16_t*)(wt + WT_GU2), DM, 0, 1);
    conv_mat(F, ((const float*)(const GAS float*)F.ap->in[25]) + (size_t)l * DM * DFF, DM, DFF, DFF, (bf16_t*)(wt + WT_GU2), DM, 0, 2);
    conv_mat(F, ((const float*)(const GAS float*)F.ap->in[26]) + (size_t)l * DFF * DM, DFF, DM, DM, (bf16_t*)(wt + WT_D2), DFF, 0, 0);
    conv_mat(F, ((const float*)(const GAS float*)F.ap->in[27]) + (size_t)l * DM * DM, DM, DM, DM, (bf16_t*)(wt + WT_PLE), XBLD, 0, 1);
    conv_mat(F, ((const float*)(const GAS float*)F.ap->in[28]) + (size_t)l * 256 * DM, 256, DM, DM, (bf16_t*)(wt + WT_PLE), XBLD, 1024, 2);
    bf16_t* wp = (bf16_t*)(wt + WT_PLE);
    for (int it = gw * 64 + F.lane; it < 2048 * 160; it += NGW * 64) { const int row = it / 160, ch = it % 160; const bool isproj = (row >> 7) & 1; const bool z = isproj ? (ch < 128) : (ch >= 128);
        if (z) *(u32x4*)(wp + (size_t)row * XBLD + ch * 8) = (u32x4){0u, 0u, 0u, 0u}; }
    }
}
__device__ __forceinline__ void p_prologue(Frame& F) {
    const int gw = F.bid * 8 + F.wave, NGW = F.G * 8;
    p_convert_weights(F, 0, 3);
    const float* x = ((const float*)(const GAS float*)F.ap->in[0]);
    for (int m = gw; m < M; m += NGW) { const f32x4* xr = (const f32x4*)(x + (size_t)m * DM) + F.lane; u32x2* o = (u32x2*)(((bf16_t*)((unsigned char*)(F.ws + WS_XB))) + (size_t)m * XBLD) + F.lane;
#pragma unroll
        for (int j = 0; j < 4; ++j) { const f32x4 v = xr[64 * j]; u32x2 w; w.x = pk2(v.x, v.y); w.y = pk2(v.z, v.w); o[64 * j] = w; } }
}
__device__ __forceinline__ void p_layernorm(Frame& F, const float* g, const float* b, const float* pl) {
    const int gw = F.bid * 8 + F.wave, NGW = F.G * 8;
    f32x4 g4[4], b4[4];
#pragma unroll
    for (int j = 0; j < 4; ++j) { g4[j] = ((const f32x4*)g)[F.lane + 64 * j]; b4[j] = ((const f32x4*)b)[F.lane + 64 * j]; }
    for (int m = gw; m < M; m += NGW) {
        f32x4* xr = (f32x4*)(((float*)(GAS float*)F.ap->out) + (size_t)m * DM) + F.lane;
        f32x4 v[4]; float s = 0.f;
#pragma unroll
        for (int j = 0; j < 4; ++j) { v[j] = xr[64 * j]; s += (v[j].x + v[j].y) + (v[j].z + v[j].w); }
        const float mean = wave_sum(s) * (1.f / DM); float s2 = 0.f;
#pragma unroll
        for (int j = 0; j < 4; ++j) { v[j] = v[j] - mean; s2 += (v[j].x * v[j].x + v[j].y * v[j].y) + (v[j].z * v[j].z + v[j].w * v[j].w); }
        const float rstd = __builtin_amdgcn_rsqf(wave_sum(s2) * (1.f / DM) + LN_EPS);
        u32x2* o = (u32x2*)(((bf16_t*)((unsigned char*)(F.ws + WS_XB))) + (size_t)m * XBLD) + F.lane;
#pragma unroll
        for (int j = 0; j < 4; ++j) { const f32x4 y = v[j] * rstd * g4[j] + b4[j]; xr[64 * j] = y; u32x2 w; w.x = pk2(y.x, y.y); w.y = pk2(y.z, y.w); o[64 * j] = w; }
        if (pl) { const f32x4 pv = ((const f32x4*)(pl + (size_t)m * 256))[F.lane]; u32x2 w; w.x = pk2(pv.x, pv.y); w.y = pk2(pv.z, pv.w); o[256] = w; }
    }
}

#define LBAR() asm volatile("s_waitcnt lgkmcnt(0)\n\ts_barrier" ::: "memory")
constexpr int LS = 68;
__device__ __forceinline__ void dot_rows(const float* X, const float* Y, int iw, int j, float (&acc)[8]) {
#pragma unroll
    for (int ii = 0; ii < 8; ++ii) acc[ii] = 0.f;
#pragma unroll 4
    for (int d4 = 0; d4 < 16; ++d4) { const f32x4 y = *(const f32x4*)(Y + j * LS + 4 * d4);
#pragma unroll
        for (int ii = 0; ii < 8; ++ii) { const f32x4 x = *(const f32x4*)(X + (iw + 8 * ii) * LS + 4 * d4); acc[ii] += (x.x * y.x + x.y * y.y) + (x.z * y.z + x.w * y.w); } }
}

constexpr int RP = 144;
__device__ __forceinline__ f32x4 tile_xyT(const float* X, const float* Y, int mt, int nt, int lane) {
    const int l15 = lane & 15, q = lane >> 4; f32x4 acc = {0.f, 0.f, 0.f, 0.f};
    const float* xa = X + (16 * mt + l15) * LS + 8 * q; const float* yb = Y + (16 * nt + l15) * LS + 8 * q;
    f32x4 xr[4], yr[4];
#pragma unroll
    for (int k = 0; k < 4; ++k) { xr[k] = *(const f32x4*)(xa + 32 * (k >> 1) + 4 * (k & 1)); yr[k] = *(const f32x4*)(yb + 32 * (k >> 1) + 4 * (k & 1)); }
    __builtin_amdgcn_sched_barrier(0);
#pragma unroll
    for (int ks = 0; ks < 2; ++ks) acc = __builtin_amdgcn_mfma_f32_16x16x32_bf16(pack8(xr[2 * ks], xr[2 * ks + 1]), pack8(yr[2 * ks], yr[2 * ks + 1]), acc, 0, 0, 0);
    return acc;
}
__device__ __forceinline__ void gdn_par_unit(Frame& F, int l, int b, int n, int h, int ul) {
    float* Q = F.ldsf; float* Kx = Q + 64 * LS; float* V = Kx + 64 * LS; float* A = V + 64 * LS; float* vec = A + 64 * LS;
    unsigned char* RAW = (unsigned char*)(vec + 320);
    bf16_t* STG = (bf16_t*)((unsigned char*)F.ldsf + 104704);
    int tid = F.tid; asm volatile("" : "+v"(tid));
    const bf16_t* hin = ((bf16_t*)(F.ws + WS_BIG)) + (size_t)b * SEQL * DINP;
    const float* cw = ((const float*)(const GAS float*)F.ap->in[17]) + (size_t)l * 4 * 1152;
    unsigned char* SCRB = (unsigned char*)(F.ws + WS_XB);
    u32x4* GW = (u32x4*)(SCRB + SC_GW) + (size_t)ul * 512; u32x4* GQK = (u32x4*)(SCRB + SC_GQK) + (size_t)ul * 512; u32x4* GQ = (u32x4*)(SCRB + SC_GQ) + (size_t)ul * 512;
    u32x4* GKT = (u32x4*)(SCRB + SC_GKT) + (size_t)ul * 512; u32x4* GU = (u32x4*)(SCRB + SC_GU) + (size_t)ul * 512; float* GV = (float*)(SCRB + SC_GVEC) + (size_t)ul * 256;
    { u32x4 r[4];
#pragma unroll
      for (int i = 0; i < 4; ++i) { const int p = tid + 512 * i, tsr = p / 536, rem = p - tsr * 536, row = rem >> 3, ch = rem & 7; const int tr = n * 64 - 3 + row;
          r[i] = (u32x4){0u, 0u, 0u, 0u};
          if (p < 1608 && tr >= 0) r[i] = *(const u32x4*)(hin + (size_t)tr * DINP + C_GQ + tsr * 384 + h * 64 + ch * 8); }
#pragma unroll
      for (int i = 0; i < 4; ++i) { const int p = tid + 512 * i, tsr = p / 536, rem = p - tsr * 536, row = rem >> 3, ch = rem & 7;
          if (p < 1608) *(u32x4*)(RAW + (tsr * 67 + row) * RP + ch * 16) = r[i]; } }
    float ag = 0.f, bg = 0.f;
    if (tid < 64) { const size_t ro = (size_t)(n * 64 + tid) * DINP; ag = bf2f(hin[ro + C_GA + h]); bg = bf2f(hin[ro + C_GB + h]); }
    const float dtb_ = ((const float*)(const GAS float*)F.ap->in[19])[l * 6 + h], alog_ = ((const float*)(const GAS float*)F.ap->in[18])[l * 6 + h];
    LBAR();
    { const int d = tid & 63;
#pragma unroll
      for (int tsr = 0; tsr < 3; ++tsr) { const int cwi = tsr * 384 + h * 64 + d; const float w0 = cw[cwi], w1 = cw[1152 + cwi], w2 = cw[2 * 1152 + cwi], w3 = cw[3 * 1152 + cwi];
          const unsigned char* rb = RAW + tsr * 67 * RP + d * 2;
          bf16_t xr[8][4];
#pragma unroll
          for (int i = 0; i < 8; ++i)
#pragma unroll
              for (int kk = 0; kk < 4; ++kk) xr[i][kk] = *(const bf16_t*)(rb + ((tid >> 6) + 8 * i + kk) * RP);
          __builtin_amdgcn_sched_barrier(0);
#pragma unroll
          for (int i = 0; i < 8; ++i) { const int t = (tid >> 6) + 8 * i;
              const float sacc = (w0 * bf2f(xr[i][0]) + w1 * bf2f(xr[i][1])) + (w2 * bf2f(xr[i][2]) + w3 * bf2f(xr[i][3]));
              F.ldsf[tsr * 64 * LS + t * LS + d] = siluf_(sacc); }
          __builtin_amdgcn_sched_barrier(0); } }
    LBAR();
    { const int r = tid >> 2, part = tid & 3; float* p = F.ldsf + (r >> 6) * 64 * LS + (r & 63) * LS + part * 16; float ss = 0.f;
#pragma unroll
      for (int i = 0; i < 16; ++i) ss += p[i] * p[i];
      ss = quad_sum(ss);
      const float sc = __builtin_amdgcn_rsqf(ss + 1e-6f) * (r < 64 ? 0.125f : 1.0f);
#pragma unroll
      for (int i = 0; i < 16; ++i) p[i] *= sc; }
    if (tid < 64) { const float xs = ag + dtb_; const float sp = xs > 20.f ? xs : log1p_pos(__expf(xs));
        float v = -__expf(alog_) * sp; vec[tid] = v; vec[64 + tid] = sigmoidf_(bg);
#pragma unroll
        for (int o = 1; o < 64; o <<= 1) { const float u = lane_read(v, (tid - o) & 63); if (tid >= o) v += u; }
        const float gl = __builtin_bit_cast(float, __builtin_amdgcn_readlane(__builtin_bit_cast(int, v), 63)); const float eg = __expf(v), et = __expf(gl - v);
        vec[128 + tid] = v; vec[192 + tid] = eg; vec[256 + tid] = et; GV[tid] = eg; GV[64 + tid] = et; }
    LBAR();
    { const int mt = F.wave >> 1, l15 = F.lane & 15, q = F.lane >> 4;
      const f32x4 gci4 = *(const f32x4*)(vec + 128 + 16 * mt + 4 * q), bi4 = *(const f32x4*)(vec + 64 + 16 * mt + 4 * q);
      const float gcj0 = vec[128 + 32 * (F.wave & 1) + l15], gcj1 = vec[128 + 32 * (F.wave & 1) + 16 + l15];
#pragma unroll
      for (int t2 = 0; t2 < 2; ++t2) { const int nt = 2 * (F.wave & 1) + t2; const int j = 16 * nt + l15;
          f32x4 kkv = {0.f, 0.f, 0.f, 0.f}, qkv = {0.f, 0.f, 0.f, 0.f};
          if (nt <= mt) { kkv = tile_xyT(Kx, Kx, mt, nt, F.lane); qkv = tile_xyT(Q, Kx, mt, nt, F.lane); }
          const float gcj = t2 ? gcj1 : gcj0;
#pragma unroll
          for (int jj = 0; jj < 4; ++jj) { const int i = 16 * mt + 4 * q + jj; const float dec = (j <= i) ? __expf(fminf(gci4[jj] - gcj, 0.f)) : 0.f;
              A[i * LS + j] = (j < i) ? bi4[jj] * kkv[jj] * dec : 0.f;
              STG[frag_off(i, j)] = (bf16_t)f2bf(qkv[jj] * dec); } } }
    { float fv[16], fs[16];
#pragma unroll
      for (int i = 0; i < 16; ++i) { const int which = i >> 3, rem = tid + 512 * (i & 7), cc = rem >> 6, r = rem & 63;
          fv[i] = F.ldsf[which * 64 * LS + cc * LS + r]; fs[i] = vec[192 + 64 * which + cc]; }
      __builtin_amdgcn_sched_barrier(0);
#pragma unroll
      for (int i = 0; i < 16; ++i) fv[i] *= fs[i];
#pragma unroll
      for (int i = 0; i < 16; ++i) { const int which = i >> 3, rem = tid + 512 * (i & 7), cc = rem >> 6, r = rem & 63;
          if (which == 0) STG[4096 + frag_off(cc, r)] = (bf16_t)f2bf(fv[i]);
          else STG[8192 + frag_off(r, cc)] = (bf16_t)f2bf(fv[i]); } }
    LBAR();
    { const u32x4* sg = (const u32x4*)STG; GQK[tid] = sg[tid]; GQ[tid] = sg[512 + tid]; GKT[tid] = sg[1024 + tid]; }
    { constexpr int XL = 132; float* XS = vec + 320;
      { float xv[16];
        const bool isU = (F.wave & 1) == 0;
        const float* src0 = (isU ? V : Kx) + (tid & 63);
        float xb[16], xe[16];
#pragma unroll
        for (int i = 0; i < 16; ++i) { const int r = (tid >> 7) + 4 * i; xv[i] = src0[r * LS]; xb[i] = vec[64 + r]; xe[i] = vec[192 + r]; }
        __builtin_amdgcn_sched_barrier(0);
#pragma unroll
        for (int i = 0; i < 16; ++i) xv[i] = xv[i] * xb[i] * (isU ? 1.0f : xe[i]);
#pragma unroll
        for (int i = 0; i < 16; ++i) { const int idx = tid + 512 * i, r = idx >> 7, c = idx & 127; XS[r * XL + c] = xv[i]; } }
      LBAR();
#pragma unroll 1
      for (int ib = 0; ib < 4; ++ib) {
          if (ib > 0) { const int c = tid & 127, r0 = 16 * ib + (tid >> 7) * 4; float s0 = 0.f, s1 = 0.f, s2 = 0.f, s3 = 0.f;
#pragma unroll 2
              for (int j = 0; j < 16 * ib; j += 4) { const float x0 = XS[j * XL + c], x1 = XS[(j + 1) * XL + c], x2 = XS[(j + 2) * XL + c], x3 = XS[(j + 3) * XL + c];
                  const f32x4 a0 = *(const f32x4*)(A + r0 * LS + j), a1 = *(const f32x4*)(A + (r0 + 1) * LS + j), a2 = *(const f32x4*)(A + (r0 + 2) * LS + j), a3 = *(const f32x4*)(A + (r0 + 3) * LS + j);
                  s0 += (a0.x * x0 + a0.y * x1) + (a0.z * x2 + a0.w * x3); s1 += (a1.x * x0 + a1.y * x1) + (a1.z * x2 + a1.w * x3);
                  s2 += (a2.x * x0 + a2.y * x1) + (a2.z * x2 + a2.w * x3); s3 += (a3.x * x0 + a3.y * x1) + (a3.z * x2 + a3.w * x3); }
              XS[r0 * XL + c] -= s0; XS[(r0 + 1) * XL + c] -= s1; XS[(r0 + 2) * XL + c] -= s2; XS[(r0 + 3) * XL + c] -= s3;
              LBAR(); }
          {
              const int c = tid >> 2, k = tid & 3; float xk[4];
              const float* Ab = A + (16 * ib) * LS + 16 * ib + k;
#pragma unroll
              for (int i = 0; i < 4; ++i) xk[i] = XS[(16 * ib + 4 * i + k) * XL + c];
              float av[16][4];
#pragma unroll
              for (int r = 1; r < 16; ++r)
#pragma unroll
                  for (int j4 = 0; j4 <= ((r - 1) >> 2); ++j4) av[r][j4] = Ab[r * LS + 4 * j4];
              __builtin_amdgcn_sched_barrier(0);
#pragma unroll
              for (int r = 1; r < 16; ++r) { float part = 0.f;
#pragma unroll
                  for (int j4 = 0; j4 <= ((r - 1) >> 2); ++j4) part += av[r][j4] * xk[j4];
                  const float tot = quad_sum(part);
                  if (k == (r & 3)) xk[r >> 2] -= tot; }
#pragma unroll
              for (int i = 0; i < 4; ++i) XS[(16 * ib + 4 * i + k) * XL + c] = xk[i]; }
          LBAR();
      }
      bf16_t* ST2 = (bf16_t*)Q;
      { float xv[16];
#pragma unroll
        for (int i = 0; i < 16; ++i) { const int idx = tid + 512 * i, r = idx >> 7, c = idx & 127; xv[i] = XS[r * XL + c]; }
        __builtin_amdgcn_sched_barrier(0);
#pragma unroll
        for (int i = 0; i < 16; ++i) { const int r = (tid >> 7) + 4 * i, cc = tid & 63; const bf16_t v = (bf16_t)f2bf(xv[i]);
            if ((F.wave & 1) == 0) ST2[cfrag_off(r, cc)] = v; else ST2[4096 + frag_off(r, cc)] = v; } }
      LBAR();
      { const u32x4* sg = (const u32x4*)ST2; GU[tid] = sg[tid]; GW[tid] = sg[512 + tid]; }
    }
    LBAR();
}

__device__ __forceinline__ void ret_par_unit(Frame& F, int l, int b, int n, int h, int ul) {
    float* Q = F.ldsf; float* Kx = Q + 64 * LS; float* V = Kx + 64 * LS; float* gp = V + 64 * LS;
    unsigned char* RAW = (unsigned char*)F.ldsf + 53248;
    bf16_t* STG = (bf16_t*)((unsigned char*)F.ldsf + 80896);
    int tid = F.tid; asm volatile("" : "+v"(tid));
    const bf16_t* hin = ((bf16_t*)(F.ws + WS_BIG)) + (size_t)b * SEQL * DINP;
    const int* pos = (const int*)(const GAS int*)F.ap->in[2] + (size_t)b * SEQL + n * 64;
    unsigned char* SCRB = (unsigned char*)(F.ws + WS_XB);
    u32x4* GSC = (u32x4*)(SCRB + SC_RSC) + (size_t)ul * 512; u32x4* GQX = (u32x4*)(SCRB + SC_RQX) + (size_t)ul * 512;
    u32x4* GKT = (u32x4*)(SCRB + SC_RKT) + (size_t)ul * 512; u32x4* GVT = (u32x4*)(SCRB + SC_RVT) + (size_t)ul * 512;
    const float lg = (h == 0) ? -0.031748698314580f : (h == 1) ? -0.015748356968139f : (h == 2) ? -0.007843177461025f : -0.003913899321136f;
    if (tid < 65) gp[tid] = __expf((float)tid * lg);
    int posv[4];
#pragma unroll
    for (int k = 0; k < 4; ++k) posv[k] = pos[(tid >> 5) + 16 * k];
    { u32x4 r[3];
#pragma unroll
      for (int i = 0; i < 3; ++i) { const int p = tid + 512 * i, tsr = p >> 9, rem = p & 511, row = rem >> 3, ch = rem & 7;
          r[i] = *(const u32x4*)(hin + (size_t)(n * 64 + row) * DINP + tsr * 256 + h * 64 + ch * 8); }
#pragma unroll
      for (int i = 0; i < 3; ++i) { const int p = tid + 512 * i, tsr = p >> 9, rem = p & 511, row = rem >> 3, ch = rem & 7; *(u32x4*)(RAW + (tsr * 64 + row) * RP + ch * 16) = r[i]; } }
    LBAR();
    { bf16_t xa[8], xb2[8], vr[8];
      const int i = tid & 31;
#pragma unroll
      for (int it = 0; it < 8; ++it) { const int tsr = it >> 2, t = (tid >> 5) + 16 * (it & 3); const unsigned char* rb = RAW + (tsr * 64 + t) * RP; xa[it] = *(const bf16_t*)(rb + i * 2); xb2[it] = *(const bf16_t*)(rb + (i + 32) * 2); }
#pragma unroll
      for (int it = 0; it < 8; ++it) { const int idx = tid + 512 * it, t = idx >> 6, d = idx & 63; vr[it] = *(const bf16_t*)(RAW + (128 + t) * RP + d * 2); }
      __builtin_amdgcn_sched_barrier(0);
      const double invf = INVF_REV[i];
#pragma unroll
      for (int it = 0; it < 8; ++it) { const int tsr = it >> 2, t = (tid >> 5) + 16 * (it & 3);
          const float x1 = bf2f(xa[it]), x2 = bf2f(xb2[it]);
          const double rev = (double)posv[it & 3] * invf; const float fr = (float)(rev - __builtin_rint(rev));
          const float cs = __builtin_amdgcn_cosf(fr), sn = __builtin_amdgcn_sinf(fr); const float sc = tsr ? 1.0f : 0.125f;
          float* dst = F.ldsf + tsr * 64 * LS + t * LS; dst[i] = (x1 * cs - x2 * sn) * sc; dst[i + 32] = (x2 * cs + x1 * sn) * sc; }
#pragma unroll
      for (int it = 0; it < 8; ++it) { const int idx = tid + 512 * it, t = idx >> 6, d = idx & 63; V[t * LS + d] = bf2f(vr[it]); } }
    LBAR();
    { const int mt = F.wave >> 1, l15 = F.lane & 15, q = F.lane >> 4;
#pragma unroll
      for (int t2 = 0; t2 < 2; ++t2) { const int nt = 2 * (F.wave & 1) + t2; const int j = 16 * nt + l15; const f32x4 sc = tile_xyT(Q, Kx, mt, nt, F.lane);
#pragma unroll
          for (int jj = 0; jj < 4; ++jj) { const int i = 16 * mt + 4 * q + jj; const int dd = i > j ? i - j : j - i; STG[frag_off(i, j)] = (bf16_t)f2bf(sc[jj] * gp[dd]); } } }
    { float fv[24], fs[24];
#pragma unroll
      for (int i = 0; i < 24; ++i) { const int which = i >> 3, rem = tid + 512 * (i & 7), cc = rem >> 6, r = rem & 63;
          fs[i] = (which == 0) ? gp[cc + 1] : (which == 1) ? gp[63 - cc] : 1.0f; fv[i] = F.ldsf[which * 64 * LS + cc * LS + r]; }
      __builtin_amdgcn_sched_barrier(0);
#pragma unroll
      for (int i = 0; i < 24; ++i) fv[i] *= fs[i];
#pragma unroll
      for (int i = 0; i < 24; ++i) { const int which = i >> 3, rem = tid + 512 * (i & 7), cc = rem >> 6, r = rem & 63;     const bf16_t v = (bf16_t)f2bf(fv[i]);
          if (which == 0) STG[4096 + frag_off(cc, r)] = v; else if (which == 1) STG[8192 + frag_off(r, cc)] = v; else STG[12288 + bfrag_off(cc, r)] = v; } }
    LBAR();
    { const u32x4* sg = (const u32x4*)STG; GSC[tid] = sg[tid]; GQX[tid] = sg[512 + tid]; GKT[tid] = sg[1024 + tid]; GVT[tid] = sg[1536 + tid]; }
    LBAR();
}

constexpr int LP = 65;
__device__ __forceinline__ void lru_par_unit(Frame& F, int l, int b, int n, int g) {
    float* XC = F.ldsf; float* WA = XC + 64 * LS; float* WX = WA + 64 * LS; float* AA = WX + 64 * LS; float* BB = AA + 64 * LP;
    int tid = F.tid; asm volatile("" : "+v"(tid));
    const bf16_t* hin = ((bf16_t*)(F.ws + WS_BIG)) + (size_t)b * SEQL * DINP;
    const float* wa = ((const float*)(const GAS float*)F.ap->in[12]) + (size_t)(l * 6 + g) * 4096; const float* wx = ((const float*)(const GAS float*)F.ap->in[14]) + (size_t)(l * 6 + g) * 4096;
    const float* cw = ((const float*)(const GAS float*)F.ap->in[10]) + (size_t)l * 4 * 384; const float* cb = ((const float*)(const GAS float*)F.ap->in[11]) + (size_t)l * 384;
    float pba[2], pbx[2], plam[2];
#pragma unroll
    for (int t2 = 0; t2 < 2; ++t2) { const int ch = g * 64 + 32 * (F.wave & 1) + 16 * t2 + (F.lane & 15);
        pba[t2] = ((const float*)(const GAS float*)F.ap->in[13])[l * 384 + ch]; pbx[t2] = ((const float*)(const GAS float*)F.ap->in[15])[l * 384 + ch]; plam[t2] = ((const float*)(const GAS float*)F.ap->in[16])[l * 384 + ch]; }
    unsigned char* RAWX = (unsigned char*)F.ldsf + 85504;
    unsigned char* RAWG = RAWX + 67 * RP;
    { f32x4 wv[4]; u32x4 r[3];
#pragma unroll
      for (int i = 0; i < 2; ++i) { wv[i] = ((const f32x4*)wa)[tid + 512 * i]; wv[2 + i] = ((const f32x4*)wx)[tid + 512 * i]; }
#pragma unroll
      for (int i = 0; i < 3; ++i) { const int p = tid + 512 * i; r[i] = (u32x4){0u, 0u, 0u, 0u};
          if (p < 536) { const int row = p >> 3, ch = p & 7, tr = n * 64 - 3 + row; if (tr >= 0) r[i] = *(const u32x4*)(hin + (size_t)tr * DINP + C_LX + g * 64 + ch * 8); }
          else if (p < 1048) { const int q = p - 536, row = q >> 3, ch = q & 7; r[i] = *(const u32x4*)(hin + (size_t)(n * 64 + row) * DINP + C_LG + g * 64 + ch * 8); } }
#pragma unroll
      for (int i = 0; i < 2; ++i) { const int e0 = 4 * (tid + 512 * i), ii = e0 >> 6, j0 = e0 & 63;
#pragma unroll
          for (int k = 0; k < 4; ++k) { WA[(j0 + k) * LS + ii] = wv[i][k]; WX[(j0 + k) * LS + ii] = wv[2 + i][k]; } }
#pragma unroll
      for (int i = 0; i < 3; ++i) { const int p = tid + 512 * i;
          if (p < 536) *(u32x4*)(RAWX + (p >> 3) * RP + (p & 7) * 16) = r[i];
          else if (p < 1048) { const int q = p - 536; *(u32x4*)(RAWG + (q >> 3) * RP + (q & 7) * 16) = r[i]; } } }
    LBAR();
    { const int c = tid & 63, ch = g * 64 + c; const float w0 = cw[ch], w1 = cw[384 + ch], w2 = cw[768 + ch], w3 = cw[1152 + ch], cbv = cb[ch];
      const unsigned char* rb = RAWX + c * 2; bf16_t xr[8][4];
#pragma unroll
      for (int i = 0; i < 8; ++i)
#pragma unroll
          for (int kk = 0; kk < 4; ++kk) xr[i][kk] = *(const bf16_t*)(rb + ((tid >> 6) + 8 * i + kk) * RP);
      __builtin_amdgcn_sched_barrier(0);
#pragma unroll
      for (int i = 0; i < 8; ++i) { const int t = (tid >> 6) + 8 * i;
          XC[t * LS + c] = cbv + ((w0 * bf2f(xr[i][0]) + w1 * bf2f(xr[i][1])) + (w2 * bf2f(xr[i][2]) + w3 * bf2f(xr[i][3]))); } }
    LBAR();
    { const int mt = F.wave >> 1, l15 = F.lane & 15, q = F.lane >> 4;
#pragma unroll
      for (int t2 = 0; t2 < 2; ++t2) { const int nt = 2 * (F.wave & 1) + t2; const int j = 16 * nt + l15, ch = g * 64 + j;
          const f32x4 accA = tile_xyT(XC, WA, mt, nt, F.lane), accX = tile_xyT(XC, WX, mt, nt, F.lane);
          const float ba = pba[t2], bx = pbx[t2], lam = plam[t2];
          const float ls = (-lam > 20.f) ? lam : -log1p_pos(__expf(-lam));
#pragma unroll
          for (int jj = 0; jj < 4; ++jj) { const int t = 16 * mt + 4 * q + jj; const float r = sigmoidf_(accA[jj] + ba), ig = sigmoidf_(accX[jj] + bx);
              const float la = 8.0f * r * ls; const float a = __expf(la); const float bc = __builtin_amdgcn_sqrtf(fmaxf(one_minus_exp(2.0f * la), 0.f)) * (ig * XC[t * LS + j]);
              AA[t * LP + j] = a; BB[t * LP + j] = bc; } } }
    LBAR();
    { const int w = tid >> 6, c = tid & 63; float hl[8], al[8]; float hcur = 0.f, ac = 1.f;
#pragma unroll
      for (int k = 0; k < 8; ++k) { hl[k] = BB[(8 * w + k) * LP + c]; al[k] = AA[(8 * w + k) * LP + c]; }
#pragma unroll
      for (int k = 0; k < 8; ++k) { hcur = al[k] * hcur + hl[k]; ac *= al[k]; hl[k] = hcur; al[k] = ac; }
      float* SEG = (float*)(RAWX);
      SEG[(w * 2) * 64 + c] = hcur; SEG[(w * 2 + 1) * 64 + c] = ac;
      LBAR();
      float ch_ = 0.f, ca_ = 1.f;
#pragma unroll
      for (int j = 0; j < 7; ++j) if (j < w) { const float hj = SEG[(j * 2) * 64 + c], aj = SEG[(j * 2 + 1) * 64 + c]; ch_ = aj * ch_ + hj; ca_ *= aj; }
#pragma unroll
      for (int k = 0; k < 8; ++k) { BB[(8 * w + k) * LP + c] = hl[k] + al[k] * ch_; AA[(8 * w + k) * LP + c] = al[k] * ca_; }
      if (w == 7) { const size_t so = (size_t)(b * 128 + n) * 384 + g * 64 + c; ((float*)(((unsigned char*)(F.ws + WS_XB)) + SC_LSH))[so] = hl[7] + al[7] * ch_; ((float*)(((unsigned char*)(F.ws + WS_XB)) + SC_LSA))[so] = al[7] * ca_; } }
    LBAR();
    bf16_t* P2 = ((bf16_t*)(F.ws + WS_BIG)) + (size_t)b * SEQL * DINP + C_LG;
#pragma unroll 2
    for (int i = 0; i < 8; ++i) { const int idx = tid + 512 * i, t = idx >> 6, c = idx & 63, ch = g * 64 + c, tok = n * 64 + t;
        const float ge = gelu_tanh(bf2f(*(const bf16_t*)(RAWG + t * RP + c * 2)));
        ((bf16_t*)(F.ws + WS_O))[((size_t)b * SEQL + tok) * DM + O_L + ch] = (bf16_t)f2bf(BB[t * LP + c] * ge);
        P2[(size_t)tok * DINP + ch] = (bf16_t)f2bf(AA[t * LP + c] * ge); }
    LBAR();
}

#ifndef PMASK
#define PMASK 7
#endif
#define PSEL(b) ((PMASK & (b)) != 0)
__device__ __forceinline__ void p_mix_par(Frame& F, int l) {
    for (int u = F.bid; u < 16384; u += F.G) {
        if (u < 6144) { const int h = u % 6, n = (u / 6) & 127, b = u / 768; if (PSEL(1)) gdn_par_unit(F, l, b, n, h, u); }
        else if (u < 10240) { const int v = u - 6144; const int h = v & 3, n = (v >> 2) & 127, b = v >> 9; if (PSEL(2)) ret_par_unit(F, l, b, n, h, v); }
        else { const int v = u - 10240; const int g = v % 6, n = (v / 6) & 127, b = v / 768; if (PSEL(4)) lru_par_unit(F, l, b, n, g); }
    }
}

#define MFMA16(a, b, c) __builtin_amdgcn_mfma_f32_16x16x32_bf16((a), (b), (c), 0, 0, 0)
template <bool GDN> __device__ __forceinline__ size_t seq_tile_base(int k) {
    if (GDN) return k == 0 ? SC_GW : k == 1 ? SC_GQ : k == 2 ? SC_GQK : k == 3 ? SC_GKT : SC_GU;
    return k == 0 ? SC_RQX : k == 1 ? SC_RSC : k == 2 ? SC_RKT : SC_RVT;
}
template <bool GDN>
__device__ __forceinline__ void seq_chain(Frame& F, int l, int b, int h) {
    constexpr int NT = GDN ? 5 : 4, NR = 2 * NT + 2;
    constexpr int EOFF = NT * 8192, SLOT = EOFF + 64, RING = 0, OUTB = 2 * SLOT, OUTSZ = 64 * 68 * 4;
    const int w = F.wave, lane = F.lane, q = lane >> 4, l15 = lane & 15;
    LAS unsigned char* const L = F.lds;
    const bf16_t* hin = ((bf16_t*)(F.ws + WS_BIG)) + (size_t)b * SEQL * DINP;
    const int zcol = (GDN ? C_GZ : C_RG) + h * 64;
    const size_t ustride = GDN ? 6 : 4, u0 = (size_t)(b * 128) * ustride + h;
    if (w >= 4) {
        const int lt = F.tid - 256, ch = lt & 7, r0 = lt >> 3;
        float gn[8];
#pragma unroll
        for (int k = 0; k < 8; ++k) gn[k] = GDN ? ((const float*)(const GAS float*)F.ap->in[20])[l * 64 + 8 * ch + k] : ((const float*)(const GAS float*)F.ap->in[9])[l * 256 + h * 64 + 8 * ch + k];
        bf16_t* const obase = ((bf16_t*)(F.ws + WS_O)) + (size_t)b * SEQL * DM + (GDN ? O_G : O_R) + h * 64 + 8 * ch;
        u32x4 R0[2 * NT], R1[2 * NT], R2[2 * NT], Z0[2], Z1[2], Z2[2]; float E0 = 0.f, E1 = 0.f, E2 = 0.f;
#define SEQ_LOAD(R, E, nn) do { if ((nn) < NCH) { const size_t un = u0 + (size_t)(nn) * ustride; \
            _Pragma("unroll") for (int k = 0; k < NT; ++k) { const u32x4* src = (const u32x4*)((unsigned char*)(F.ws + WS_XB) + seq_tile_base<GDN>(k)) + un * 512 + lt; R[2 * k] = src[0]; R[2 * k + 1] = src[256]; } \
            if (GDN) E = ((const float*)((unsigned char*)(F.ws + WS_XB) + SC_GVEC))[un * 256 + 63]; } } while (0)
#define SEQ_LOADZ(Z, nn) do { if ((nn) < NCH) { _Pragma("unroll") for (int i = 0; i < 2; ++i) Z[i] = *(const u32x4*)(hin + (size_t)((nn) * 64 + r0 + 32 * i) * DINP + zcol + ch * 8); } } while (0)
#define SEQ_STORE(R, E, nn) do { LAS unsigned char* sl = L + RING + ((nn) & 1) * SLOT; \
            _Pragma("unroll") for (int k = 0; k < NT; ++k) { *(LAS u32x4*)(sl + k * 8192 + lt * 16) = R[2 * k]; *(LAS u32x4*)(sl + k * 8192 + (lt + 256) * 16) = R[2 * k + 1]; } \
            if (GDN && lt == 0) *(LAS float*)(sl + EOFF) = E; } while (0)
#define SEQ_OUT(ZQ, nn) do { const LAS float* ob = (const LAS float*)(L + OUTB + ((nn) & 1) * OUTSZ); \
            _Pragma("unroll") for (int i = 0; i < 2; ++i) { const int rr = r0 + 32 * i; const f32x4 o0 = *(const LAS f32x4*)(ob + rr * 68 + 8 * ch), o1 = *(const LAS f32x4*)(ob + rr * 68 + 8 * ch + 4); \
                float s2 = ((o0[0] * o0[0] + o0[1] * o0[1]) + (o0[2] * o0[2] + o0[3] * o0[3])) + ((o1[0] * o1[0] + o1[1] * o1[1]) + (o1[2] * o1[2] + o1[3] * o1[3])); \
                float s1 = ((o0[0] + o0[1]) + (o0[2] + o0[3])) + ((o1[0] + o1[1]) + (o1[2] + o1[3])); \
                s2 += __builtin_bit_cast(float, __builtin_amdgcn_update_dpp(0, __builtin_bit_cast(int, s2), 0xB1, 0xF, 0xF, true)); s2 += __builtin_bit_cast(float, __builtin_amdgcn_update_dpp(0, __builtin_bit_cast(int, s2), 0x4E, 0xF, 0xF, true)); \
                s2 += __builtin_bit_cast(float, __builtin_amdgcn_update_dpp(0, __builtin_bit_cast(int, s2), 0x141, 0xF, 0xF, true)); \
                float mu = 0.f, rs; \
                if (GDN) { rs = __builtin_amdgcn_rsqf(s2 * (1.0f / 64.0f) + 1e-6f); } \
                else { s1 += __builtin_bit_cast(float, __builtin_amdgcn_update_dpp(0, __builtin_bit_cast(int, s1), 0xB1, 0xF, 0xF, true)); s1 += __builtin_bit_cast(float, __builtin_amdgcn_update_dpp(0, __builtin_bit_cast(int, s1), 0x4E, 0xF, 0xF, true)); \
                    s1 += __builtin_bit_cast(float, __builtin_amdgcn_update_dpp(0, __builtin_bit_cast(int, s1), 0x141, 0xF, 0xF, true)); \
                    mu = s1 * (1.0f / 64.0f); rs = __builtin_amdgcn_rsqf(fmaxf(s2 * (1.0f / 64.0f) - mu * mu, 0.f) + 1e-5f); } \
                float y[8]; \
                _Pragma("unroll") for (int k = 0; k < 4; ++k) { const unsigned zw = ZQ[i][k]; const float z0 = __builtin_bit_cast(float, zw << 16), z1 = __builtin_bit_cast(float, zw & 0xffff0000u); \
                    const float a0 = (k < 2 ? o0[2 * k] : o1[2 * k - 4]), a1 = (k < 2 ? o0[2 * k + 1] : o1[2 * k - 3]); \
                    y[2 * k] = (a0 - mu) * rs * gn[2 * k] * siluf_(z0); y[2 * k + 1] = (a1 - mu) * rs * gn[2 * k + 1] * siluf_(z1); } \
                u32x4 ov; ov.x = pk2(y[0], y[1]); ov.y = pk2(y[2], y[3]); ov.z = pk2(y[4], y[5]); ov.w = pk2(y[6], y[7]); \
                *(u32x4*)(obase + (size_t)((nn) * 64 + rr) * DM) = ov; } } while (0)
#define SEQ_LITER(R, E, ZQ, nn) do { if ((nn) <= NCH) { if ((nn) < NCH) { SEQ_STORE(R, E, nn); } SEQ_LOAD(R, E, (nn) + 3); LBAR(); \
            if ((nn) > 0) { SEQ_OUT(ZQ, (nn) - 1); } SEQ_LOADZ(ZQ, (nn) + 2); } } while (0)
        SEQ_LOAD(R0, E0, 0); SEQ_LOAD(R1, E1, 1); SEQ_LOAD(R2, E2, 2); SEQ_LOADZ(Z0, 0); SEQ_LOADZ(Z1, 1);
        for (int n = 0; n <= NCH; n += 3) { SEQ_LITER(R0, E0, Z2, n); SEQ_LITER(R1, E1, Z0, n + 1); SEQ_LITER(R2, E2, Z1, n + 2); }
#undef SEQ_LOAD
#undef SEQ_LOADZ
#undef SEQ_STORE
#undef SEQ_OUT
#undef SEQ_LITER
        return;
    }
    const float lgam = (h == 0) ? -0.031748698314580f : (h == 1) ? -0.015748356968139f : (h == 2) ? -0.007843177461025f : -0.003913899321136f;
    const float cd = __expf(64.0f * lgam);
    f32x4 S[4];
#pragma unroll
    for (int i = 0; i < 4; ++i) S[i] = (f32x4){0.f, 0.f, 0.f, 0.f};
    for (int n = 0; n <= NCH; ++n) {
        LBAR();
        if (n == NCH) break;
        LAS unsigned char* sl = L + RING + (n & 1) * SLOT;
        const LAS bf16x8* T0 = (const LAS bf16x8*)(sl) + lane; const LAS bf16x8* T1 = (const LAS bf16x8*)(sl + 8192) + lane;
        const LAS bf16x8* T2 = (const LAS bf16x8*)(sl + 2 * 8192) + lane; const LAS bf16x8* T3 = (const LAS bf16x8*)(sl + 3 * 8192) + lane;
        f32x4 Oa[4]; const f32x4 zero4 = {0.f, 0.f, 0.f, 0.f};
        bf16x8 Sb[2]; Sb[0] = pack8(S[0], S[1]); Sb[1] = pack8(S[2], S[3]);
        bf16x8 fa[8], fb[8];
#pragma unroll
        for (int f = 0; f < 8; ++f) { fa[f] = T0[f * 64]; fb[f] = T1[f * 64]; }
        if (GDN) {
            f32x4 P[4]; bf16x4 uf[4];
#pragma unroll
            for (int mt = 0; mt < 4; ++mt) uf[mt] = *(const LAS bf16x4*)(sl + 4 * 8192 + ((mt * 4 + w) * 64 + lane) * 8);
            const float egl = *(const LAS float*)(sl + EOFF);
            __builtin_amdgcn_sched_barrier(0);
#pragma unroll
            for (int mt = 0; mt < 4; ++mt) { P[mt] = MFMA16(fa[mt * 2], Sb[0], zero4); Oa[mt] = MFMA16(fb[mt * 2], Sb[0], zero4); }
#pragma unroll
            for (int mt = 0; mt < 4; ++mt) { P[mt] = MFMA16(fa[mt * 2 + 1], Sb[1], P[mt]); Oa[mt] = MFMA16(fb[mt * 2 + 1], Sb[1], Oa[mt]); }
            __builtin_amdgcn_sched_barrier(0);
#pragma unroll
            for (int f = 0; f < 8; ++f) { fa[f] = T2[f * 64]; fb[f] = T3[f * 64]; }
            f32x4 vn[4];
#pragma unroll
            for (int mt = 0; mt < 4; ++mt) { vn[mt] = unpack4(uf[mt]) - P[mt]; S[mt] = S[mt] * egl; }
            bf16x8 vnb[2]; vnb[0] = pack8(vn[0], vn[1]); vnb[1] = pack8(vn[2], vn[3]);
            __builtin_amdgcn_sched_barrier(0);
#pragma unroll
            for (int mt = 0; mt < 4; ++mt) { Oa[mt] = MFMA16(fa[mt * 2], vnb[0], Oa[mt]); S[mt] = MFMA16(fb[mt * 2], vnb[0], S[mt]); }
#pragma unroll
            for (int mt = 0; mt < 4; ++mt) { Oa[mt] = MFMA16(fa[mt * 2 + 1], vnb[1], Oa[mt]); S[mt] = MFMA16(fb[mt * 2 + 1], vnb[1], S[mt]); }
        } else {
            bf16x8 fc[8]; bf16x8 Vb[2]; Vb[0] = *(const LAS bf16x8*)(sl + 3 * 8192 + (w * 64 + lane) * 16); Vb[1] = *(const LAS bf16x8*)(sl + 3 * 8192 + ((4 + w) * 64 + lane) * 16);
#pragma unroll
            for (int f = 0; f < 8; ++f) fc[f] = T2[f * 64];
            __builtin_amdgcn_sched_barrier(0);
#pragma unroll
            for (int mt = 0; mt < 4; ++mt) { Oa[mt] = MFMA16(fa[mt * 2], Sb[0], zero4); S[mt] = S[mt] * cd; }
#pragma unroll
            for (int mt = 0; mt < 4; ++mt) { Oa[mt] = MFMA16(fa[mt * 2 + 1], Sb[1], Oa[mt]); S[mt] = MFMA16(fc[mt * 2], Vb[0], S[mt]); }
#pragma unroll
            for (int mt = 0; mt < 4; ++mt) { Oa[mt] = MFMA16(fb[mt * 2], Vb[0], Oa[mt]); S[mt] = MFMA16(fc[mt * 2 + 1], Vb[1], S[mt]); }
#pragma unroll
            for (int mt = 0; mt < 4; ++mt) Oa[mt] = MFMA16(fb[mt * 2 + 1], Vb[1], Oa[mt]);
        }
        LAS float* ob = (LAS float*)(L + OUTB + (n & 1) * OUTSZ) + w * 16 + l15;
#pragma unroll
        for (int mt = 0; mt < 4; ++mt)
#pragma unroll
            for (int j = 0; j < 4; ++j) ob[(16 * mt + 4 * q + j) * 68] = Oa[mt][j];
    }
}
__device__ __forceinline__ void lru_seq_item(Frame& F, int b, int g, int n) {
    const int c = F.lane, ch = g * 64 + c;
    const float* SH = (const float*)((unsigned char*)(F.ws + WS_XB) + SC_LSH) + (size_t)(b * 128) * 384 + ch; const float* SA = (const float*)((unsigned char*)(F.ws + WS_XB) + SC_LSA) + (size_t)(b * 128) * 384 + ch;
    const bf16_t* P2 = ((const bf16_t*)(F.ws + WS_BIG)) + ((size_t)b * SEQL + n * 64) * DINP + C_LG + ch;
    bf16_t* op = ((bf16_t*)(F.ws + WS_O)) + ((size_t)b * SEQL + n * 64) * DM + O_L + ch;
    float carry = 0.f;
    int k = 0;
    for (; k + 8 <= n; k += 8) { float sh[8], sa[8];
#pragma unroll
        for (int i = 0; i < 8; ++i) { sh[i] = SH[(size_t)(k + i) * 384]; sa[i] = SA[(size_t)(k + i) * 384]; }
#pragma unroll
        for (int i = 0; i < 8; ++i) carry = sh[i] + sa[i] * carry; }
    for (; k < n; ++k) carry = SH[(size_t)k * 384] + SA[(size_t)k * 384] * carry;
#pragma unroll 1
    for (int t0 = 0; t0 < 64; t0 += 16) { bf16_t r1[16], r2[16];
#pragma unroll
        for (int i = 0; i < 16; ++i) { r1[i] = op[(size_t)(t0 + i) * DM]; r2[i] = P2[(size_t)(t0 + i) * DINP]; }
        __builtin_amdgcn_sched_barrier(0);
#pragma unroll
        for (int i = 0; i < 16; ++i) op[(size_t)(t0 + i) * DM] = (bf16_t)f2bf(bf2f(r1[i]) + bf2f(r2[i]) * carry); }
}
__device__ __forceinline__ void p_mix_seq(Frame& F, int l) {
    const int ci = F.bid;
    if (ci < 48) { const int b = ci / 6, h = ci % 6; seq_chain<true>(F, l, b, h); }
    else if (ci < 80) { const int v = ci - 48; const int b = v >> 2, h = v & 3; seq_chain<false>(F, l, b, h); }
    else { const int nwv = (F.G - 80) * 8;
        for (int item = (ci - 80) * 8 + F.wave; item < 6144; item += nwv) { const int n = item & 127, v = item >> 7; const int b = v / 6, g = v % 6; lru_seq_item(F, b, g, n); } }
}

#ifndef GMASK
#define GMASK 63
#endif
#define GSEL(b) ((GMASK & (b)) != 0)
__global__ void __launch_bounds__(512, 2) fwd(Args args) {
    extern __shared__ __attribute__((aligned(16))) unsigned char lds[];
    const int lo = args.ph_lo, hi = args.ph_hi;
    if (hi - lo > 1) cg::this_grid().sync();
    const int wv0 = __builtin_amdgcn_readfirstlane((int)threadIdx.x >> 6);
#ifdef PROBE_CAT
    if (threadIdx.x == 0) { volatile unsigned long long* ptm = (volatile unsigned long long*)(lds + 143360); ptm[0] = __builtin_amdgcn_s_memrealtime(); ptm[1] = 0ull; }
#endif
    for (int ph = lo; ph < hi; ++ph) {
        if (ph > lo) {
            asm volatile("s_waitcnt vmcnt(0) lgkmcnt(0)\n\ts_barrier" ::: "memory");
            unsigned zb_ = 0u; asm volatile("" : "+s"(zb_));
            if (wv0 == 0 && __builtin_amdgcn_mbcnt_hi(~0u, __builtin_amdgcn_mbcnt_lo(~0u, zb_)) == 0u) {
                __builtin_amdgcn_fence(__ATOMIC_RELEASE, "agent"); asm volatile("s_waitcnt vmcnt(0) lgkmcnt(0)" ::: "memory");
                unsigned* cnt = (unsigned*)args.ws + 2048 + 64 * ph;
                __hip_atomic_fetch_add(cnt, 1u, __ATOMIC_RELAXED, __HIP_MEMORY_SCOPE_AGENT);
                while (__hip_atomic_load(cnt, __ATOMIC_RELAXED, __HIP_MEMORY_SCOPE_AGENT) < gridDim.x) __builtin_amdgcn_s_sleep(1);
                __builtin_amdgcn_fence(__ATOMIC_ACQUIRE, "agent"); asm volatile("s_waitcnt vmcnt(0) lgkmcnt(0)" ::: "memory");
            }
            asm volatile("s_waitcnt vmcnt(0) lgkmcnt(0)\n\ts_barrier" ::: "memory");
        }
        Frame F;
        { unsigned z_ = 0u; asm volatile("" : "+s"(z_));
          int t_ = (wv0 << 6) | (int)__builtin_amdgcn_mbcnt_hi(~0u, __builtin_amdgcn_mbcnt_lo(~0u, z_)); asm volatile("" : "+v"(t_));
          const CAS Args* ap_ = (const CAS Args*)__builtin_amdgcn_kernarg_segment_ptr(); asm volatile("" : "+s"(ap_)); F.ap = ap_; GAS unsigned char* w_ = (GAS unsigned char*)ap_->ws;
          F.lds = (LAS unsigned char*)lds; F.ldsf = (float*)lds; F.tid = t_; F.lane = t_ & 63; F.wave = __builtin_amdgcn_readfirstlane(t_ >> 6); int g_ = gridDim.x, b_ = blockIdx.x; asm volatile("" : "+s"(g_), "+s"(b_)); F.G = g_; F.bid = b_; F.ws = w_; }
#ifdef PROBE_CAT
        if (threadIdx.x == 0) { volatile unsigned long long* ptm = (volatile unsigned long long*)(lds + 143360); const unsigned long long tn = __builtin_amdgcn_s_memrealtime(); const int pp = ph - 1;
          const int s_ = (pp - 1) & 7; const bool hit = (pp > 0) && (PROBE_CAT >= 10 ? (s_ == PROBE_CAT - 10) : (PROBE_CAT == 3 ? s_ == 3 : PROBE_CAT == 4 ? s_ == 4 : (s_ != 3 && s_ != 4)));
          if (hit || (PROBE_CAT == 0 && pp == 0)) ptm[1] += tn - ptm[0];
          ptm[0] = tn; }
        if (ph == NPH) {
            __syncthreads();
            if (blockIdx.x == 0) { volatile unsigned long long* ptm = (volatile unsigned long long*)(lds + 143360); const float v = __builtin_amdgcn_sqrtf((float)ptm[1] * 0.01f * 1.024e-6f);
                for (int i = threadIdx.x; i < 65536; i += 512) ((float*)(GAS float*)args.out)[i] += v; }
            break; }
#endif
        if (ph == 0) { p_prologue(F); continue; }
        const int l = (ph - 1) / 8, s = (ph - 1) % 8;
        unsigned char* wt = (unsigned char*)(F.ws + WS_WT);
        bf16_t* const XBp = (bf16_t*)((unsigned char*)(F.ws + WS_XB)); bf16_t* const BIGp = (bf16_t*)(F.ws + WS_BIG); bf16_t* const OBp = (bf16_t*)(F.ws + WS_O);
        float* const Xp = (float*)(GAS float*)F.ap->out;
        if (s == 0 || s == 6) {
            { pg8::Gemm g{XBp, (const bf16_t*)(wt + (s == 0 ? WT_GU1 : WT_GU2))}; pg8::StaticOrder S; S.init(M, 2 * DFF, F.G, F.bid);
              pg8::EpiGated<0> E{BIGp, DFF}; pg8::gemm_phase<XBLD, DM, DM>(F.lds, F.tid, g, S, E); }
            if (s == 6) { pg8::Gemm g{XBp, (const bf16_t*)(wt + WT_PLE)}; pg8::StaticOrder S; S.init(M, 2048, F.G, F.bid);
              pg8::EpiGated<1> E{OBp, DM}; pg8::gemm_phase<XBLD, XBLD, XBLD, pg8::EpiGated<1>, 16>(F.lds, F.tid, g, S, E); }
            if (l == 0 && s == 6) p_convert_weights(F, 1, 1);
            if (l == 1 && s == 0) p_convert_weights(F, 1, 2);
        } else if (s == 1 || s == 7 || s == 5) {
            const int k = (s == 1) ? 0 : (s == 5) ? 1 : 2;
            const float* lg = (const float*)(const GAS float*)F.ap->in[k == 0 ? 3 : k == 1 ? 22 : 29] + l * DM; const float* lb = (const float*)(const GAS float*)F.ap->in[k == 0 ? 4 : k == 1 ? 23 : 30] + l * DM;
            const float* resid_ = (ph == 2) ? (const float*)(const GAS float*)F.ap->in[0] : (const float*)Xp;
            const float* pin_ = (s == 5) ? (const float*)(const GAS float*)F.ap->in[1] + (size_t)l * M * 256 : (const float*)nullptr;
            unsigned long long* xbuf_ = (unsigned long long*)(F.ws + WS_XBUF); unsigned* cnt_ = (unsigned*)(F.ws + WS_LNCNT) + (size_t)(l * 3 + k) * 256 * 64;
            pg8::StaticOrder S; S.init(M, DM, F.G, F.bid);
            if (s == 5) { pg8::EpiResidLN<false> E{resid_, Xp, XBp, (const bf16_t*)nullptr, pin_, 1.0f, lg, lb, xbuf_, cnt_, F.lds + 131072};
                pg8::Gemm g{OBp, (const bf16_t*)(wt + WT_OUT)}; pg8::gemm_phase<DM, DM, DM>(F.lds, F.tid, g, S, E); }
            else if (s == 1) { pg8::EpiResidLN<false> E{resid_, Xp, XBp, (const bf16_t*)nullptr, pin_, 0.5f, lg, lb, xbuf_, cnt_, F.lds + 131072};
                pg8::Gemm g{BIGp, (const bf16_t*)(wt + WT_D1)}; pg8::gemm_phase<DFF, DFF, DFF>(F.lds, F.tid, g, S, E); }
            else { pg8::EpiResidLN<true> E{resid_, Xp, XBp, (const bf16_t*)OBp, pin_, 0.5f, lg, lb, xbuf_, cnt_, F.lds + 131072};
                pg8::Gemm g{BIGp, (const bf16_t*)(wt + WT_D2)}; pg8::gemm_phase<DFF, DFF, DFF>(F.lds, F.tid, g, S, E); }
        } else if (s == 2) {
            pg8::Gemm g{XBp, (const bf16_t*)(wt + WT_IN)}; pg8::StaticOrder S; S.init(M, DINP, F.G, F.bid);
            pg8::EpiBf16 E{BIGp, DINP}; pg8::gemm_phase<XBLD, DM, DM>(F.lds, F.tid, g, S, E);
        } else if (s == 3) { p_mix_par(F, l);
        } else if (s == 4) {
#if defined(PROBE_CAT) && PROBE_CAT == 99
            unsigned long long c0_ = __builtin_amdgcn_s_memrealtime();
#endif
            p_mix_seq(F, l);
#if defined(PROBE_CAT) && PROBE_CAT == 99
            __syncthreads(); if (F.tid == 0) { volatile unsigned long long* ptm = (volatile unsigned long long*)(lds + 143360); ptm[1] += __builtin_amdgcn_s_memrealtime() - c0_; }
#endif
        }
    }
}

extern "C" void kernel_launch(void* const* d_in, const int* in_sizes, int n_in, void* d_out, int out_size, void* d_ws, size_t ws_size, hipStream_t stream) {
    static int grid = 0;
    if (grid == 0) {
        if (n_in != 31 || out_size != M * DM || ws_size < WS_END) { fprintf(stderr, "kernel_launch: unexpected shapes (n_in %d out %d ws %zu)\n", n_in, out_size, ws_size); grid = -1; return; }
        int dev = 0, cus = 0;
        hipGetDevice(&dev); hipDeviceGetAttribute(&cus, hipDeviceAttributeMultiprocessorCount, dev);
        if (hipFuncSetAttribute((const void*)fwd, hipFuncAttributeMaxDynamicSharedMemorySize, LDS_BYTES) != hipSuccess) { fprintf(stderr, "hipFuncSetAttribute failed\n"); grid = -1; return; }
        int per_cu = 0; hipOccupancyMaxActiveBlocksPerMultiprocessor(&per_cu, (const void*)fwd, 512, LDS_BYTES); (void)hipGetLastError();
        grid = 256;
        if (cus < 256) { fprintf(stderr, "kernel_launch: needs 256 CUs with one resident 512-thread workgroup each (cus %d, occupancy query %d)\n", cus, per_cu); grid = -1; }
    }
    if (grid < 0) return;
    if (hipMemsetAsync(d_ws, 0, CTL_BYTES, stream) != hipSuccess) { fprintf(stderr, "memset failed\n"); return; }
    Args a{};
    for (int i = 0; i < 31; ++i) a.in[i] = d_in[i];
    a.out = (float*)d_out; a.ws = (unsigned char*)d_ws;
#if ONE_LAUNCH
#ifdef PROBE_CAT
    a.ph_lo = 0; a.ph_hi = NPH + 1;
#else
    a.ph_lo = 0; a.ph_hi = NPH;
#endif
    void* kargs[] = {&a};
    hipError_t e = hipLaunchCooperativeKernel((const void*)fwd, dim3(grid), dim3(512), kargs, LDS_BYTES, stream);
    if (e != hipSuccess) fprintf(stderr, "cooperative launch failed: %s\n", hipGetErrorString(e));
#else
    for (int ph = 0; ph < NPH; ++ph) { a.ph_lo = ph; a.ph_hi = ph + 1; hipLaunchKernelGGL(fwd, dim3(grid), dim3(512), LDS_BYTES, stream, a); }
#endif
}
```

```cpp
#include <hip/hip_runtime.h>
#include <hip/hip_cooperative_groups.h>
#include <cstdio>
#include <cstdint>
namespace cg = cooperative_groups;

#ifndef ONE_LAUNCH
#define ONE_LAUNCH 1
#endif

#define LAS __attribute__((address_space(3)))
#define GAS __attribute__((address_space(1)))
#define CAS __attribute__((address_space(4)))
typedef unsigned short bf16_t;
typedef short bf16x8 __attribute__((ext_vector_type(8)));
typedef short bf16x4 __attribute__((ext_vector_type(4)));
typedef float f32x4 __attribute__((ext_vector_type(4)));
typedef float f32x2 __attribute__((ext_vector_type(2)));
typedef unsigned u32x4 __attribute__((ext_vector_type(4)));
typedef unsigned u32x2 __attribute__((ext_vector_type(2)));

constexpr int M = 65536, DM = 1024, DFF = 2816, DIN = 3340, DINP = 3584, SEQL = 8192, NCH = 128;
constexpr int XBLD = 1280;
constexpr float ALPHA = 1.41421356237309515f;
constexpr float LN_EPS = 1e-5f;
constexpr int C_RQ = 0, C_RK = 256, C_RV = 512, C_RG = 768, C_LX = 1024, C_LG = 1408, C_GQ = 1792, C_GK = 2176, C_GV = 2560, C_GZ = 2944, C_GA = 3328, C_GB = 3334;
constexpr int O_R = 0, O_L = 256, O_G = 640;

constexpr size_t MiB = 1u << 20;
constexpr size_t WS_WT = 1 * MiB;
constexpr size_t WT_GU1 = 0, WT_D1 = WT_GU1 + (size_t)5632 * 1024 * 2, WT_IN = WT_D1 + (size_t)1024 * 2816 * 2, WT_OUT = WT_IN + (size_t)3584 * 1024 * 2,
                 WT_GU2 = WT_OUT + (size_t)1024 * 1024 * 2, WT_D2 = WT_GU2 + (size_t)5632 * 1024 * 2, WT_PLE = WT_D2 + (size_t)1024 * 2816 * 2, WT_LAYER = WT_PLE + (size_t)2048 * 1280 * 2;
static_assert(WT_LAYER <= 48 * MiB, "weights");
constexpr size_t WS_XB = 52 * MiB;
constexpr size_t WS_BIG = 432 * MiB;
constexpr size_t WS_O = 880 * MiB;
constexpr size_t WS_XBUF = 1008 * MiB;
constexpr size_t WS_END = 1010 * MiB;
constexpr size_t WS_LNCNT = 16384;
constexpr size_t CTL_BYTES = 512 * 1024;
constexpr size_t NUG = 6144, NUR = 4096;
constexpr size_t SC_GW = 0, SC_GQK = SC_GW + NUG * 8192, SC_GQ = SC_GQK + NUG * 8192, SC_GKT = SC_GQ + NUG * 8192, SC_GU = SC_GKT + NUG * 8192, SC_GVEC = SC_GU + NUG * 8192,
                 SC_RSC = SC_GVEC + NUG * 1024, SC_RQX = SC_RSC + NUR * 8192, SC_RKT = SC_RQX + NUR * 8192, SC_RVT = SC_RKT + NUR * 8192,
                 SC_LSH = SC_RVT + NUR * 8192, SC_LSA = SC_LSH + (size_t)8 * 128 * 384 * 4, SC_END = SC_LSA + (size_t)8 * 128 * 384 * 4;
static_assert(WS_XB + SC_END <= WS_BIG, "mixer scratch");

constexpr int LDS_BYTES = 147456;
constexpr int NPH = 17;

struct Args { const void* in[31]; float* out; unsigned char* ws; int ph_lo, ph_hi; };

__device__ __forceinline__ unsigned f2bf(float f) { unsigned u = __builtin_bit_cast(unsigned, f); return (u + 0x7fffu + ((u >> 16) & 1u)) >> 16; }
__device__ __forceinline__ unsigned pk2(float lo, float hi) { return f2bf(lo) | (f2bf(hi) << 16); }
__device__ __forceinline__ float bf2f(bf16_t u) { return __builtin_bit_cast(float, (unsigned)u << 16); }
__device__ __forceinline__ float sigmoidf_(float x) { return __builtin_amdgcn_rcpf(1.0f + __expf(-x)); }
__device__ __forceinline__ float siluf_(float x) { return x * __builtin_amdgcn_rcpf(1.0f + __expf(-x)); }
__device__ __forceinline__ float log1p_pos(float e) { const float z = e * __builtin_amdgcn_rcpf(2.0f + e), z2 = z * z; const float sr = 2.0f * z * (1.0f + z2 * (0.333333333f + z2 * (0.2f + z2 * (0.142857143f + z2 * 0.111111111f)))); return e < 0.25f ? sr : __logf(1.0f + e); }
__device__ __forceinline__ float one_minus_exp(float y) { const float sr = -y * (1.0f + y * (0.5f + y * (0.166666667f + y * (0.0416666667f + y * 0.00833333333f)))); return y > -0.1f ? sr : 1.0f - __expf(y); }
__device__ __forceinline__ float gelu_tanh(float x) { const float u = 0.7978845608028654f * (x + 0.044715f * x * x * x); const float e = __expf(2.0f * u); const float th = 1.0f - 2.0f * __builtin_amdgcn_rcpf(e + 1.0f); return 0.5f * x * (1.0f + th); }
__device__ __forceinline__ bf16x8 pack8(f32x4 a, f32x4 b) { u32x4 w; w.x = pk2(a.x, a.y); w.y = pk2(a.z, a.w); w.z = pk2(b.x, b.y); w.w = pk2(b.z, b.w); return __builtin_bit_cast(bf16x8, w); }
__device__ __forceinline__ f32x4 unpack4(bf16x4 v) { f32x4 r; r.x = bf2f((bf16_t)v.x); r.y = bf2f((bf16_t)v.y); r.z = bf2f((bf16_t)v.z); r.w = bf2f((bf16_t)v.w); return r; }
__device__ __forceinline__ float wave_sum(float v) {
#pragma unroll
    for (int o = 1; o < 64; o <<= 1) v += __shfl_xor(v, o);
    return v;
}
__device__ __forceinline__ float lane_read(float v, int srclane) { return __builtin_bit_cast(float, __builtin_amdgcn_ds_bpermute(srclane << 2, __builtin_bit_cast(int, v))); }
__device__ __forceinline__ float quad_sum(float v) {
    v += __builtin_bit_cast(float, __builtin_amdgcn_update_dpp(0, __builtin_bit_cast(int, v), 0xB1, 0xF, 0xF, true));
    v += __builtin_bit_cast(float, __builtin_amdgcn_update_dpp(0, __builtin_bit_cast(int, v), 0x4E, 0xF, 0xF, true));
    return v;
}
__device__ __forceinline__ float row16_sum(float v) {
    v += __builtin_bit_cast(float, __builtin_amdgcn_update_dpp(0, __builtin_bit_cast(int, v), 0xB1, 0xF, 0xF, true));
    v += __builtin_bit_cast(float, __builtin_amdgcn_update_dpp(0, __builtin_bit_cast(int, v), 0x4E, 0xF, 0xF, true));
    v += __builtin_bit_cast(float, __builtin_amdgcn_update_dpp(0, __builtin_bit_cast(int, v), 0x141, 0xF, 0xF, true));
    v += __builtin_bit_cast(float, __builtin_amdgcn_update_dpp(0, __builtin_bit_cast(int, v), 0x140, 0xF, 0xF, true));
    return v;
}
__device__ __forceinline__ int frag_off(int row, int col) { const int mt = row >> 4, r = row & 15, ks = col >> 5, hi = (col >> 4) & 1, q = (col >> 2) & 3, lo = col & 3; return ((mt * 2 + ks) * 64 + q * 16 + r) * 8 + hi * 4 + lo; }
__device__ __forceinline__ int cfrag_off(int c, int e) { const int mt = c >> 4, q = (c >> 2) & 3, j = c & 3; return ((mt * 4 + (e >> 4)) * 64 + q * 16 + (e & 15)) * 4 + j; }
__device__ __forceinline__ int bfrag_off(int c, int e) { const int ks = c >> 5, hi = (c >> 4) & 1, q = (c >> 2) & 3, lo = c & 3; return ((ks * 4 + (e >> 4)) * 64 + q * 16 + (e & 15)) * 8 + hi * 4 + lo; }

__constant__ double INVF_REV[32] = {1.59154943091895346e-01, 1.19349370211248862e-01, 8.94994016088910133e-02, 6.71150830052272551e-02, 5.03292121044870353e-02, 3.77415847174197711e-02, 2.83021958306233987e-02, 2.12236527647776604e-02, 1.59154943091895339e-02, 1.19349370211248862e-02, 8.94994016088910237e-03, 6.71150830052272534e-03, 5.03292121044870370e-03, 3.77415847174197719e-03, 2.83021958306233987e-03, 2.12236527647776622e-03, 1.59154943091895356e-03, 1.19349370211248849e-03, 8.94994016088910237e-04, 6.71150830052272599e-04, 5.03292121044870326e-04, 3.77415847174197741e-04, 2.83021958306233954e-04, 2.12236527647776605e-04, 1.59154943091895351e-04, 1.19349370211248862e-04, 8.94994016088910182e-05, 6.71150830052272545e-05, 5.03292121044870354e-05, 3.77415847174197768e-05, 2.83021958306233961e-05, 2.12236527647776592e-05};

namespace pg8 {
constexpr int BM = 256, BK = 64, HALF = 128, HTB = HALF * BK * 2, STAGE_BYTES = 8 * HTB, NXCD = 8, WGM = 8;
__device__ __forceinline__ int lds_byte(int r, int c) { const int st = (r >> 4) * 2 + (c >> 5), rr = r & 15, cc = c & 31, ob = rr * 64 + cc * 2; return st * 1024 + (ob ^ (((ob >> 9) & 1) << 5)); }
__device__ __forceinline__ void stage_rc(int b, int& R, int& C) { const int st = b / 1024, sb = b % 1024, swz = sb ^ (((sb >> 9) & 1) << 5); R = (st >> 1) * 16 + swz / 64; C = (st & 1) * 32 + (swz % 64) / 2; }
__device__ __forceinline__ int perm32(int rho) { const int n = rho >> 4, i = rho & 15; return 8 * (i >> 2) + 4 * n + (i & 3); }
struct Unit { int pm, pn; };
struct Gemm { const bf16_t* A; const bf16_t* Bt; };
struct StaticOrder {
    int nM, nN, nwg, G, c;
    __device__ void init(int M_, int N_, int G_, int c_) { nM = M_ / BM; nN = N_ / BM; nwg = nM * nN; G = G_; c = c_; }
    __device__ bool next(int i, Unit& u) const {
        const long L = (long)i * G + c; if (L >= nwg) return false;
        int wgid = (int)L; { const int q = nwg / NXCD, r = nwg % NXCD, xcd = wgid % NXCD, off = wgid / NXCD; wgid = (xcd < r ? xcd * (q + 1) : r * (q + 1) + (xcd - r) * q) + off; }
        const int nig = WGM * nN, gid = wgid / nig, fm = gid * WGM, gsz = (nM - fm) < WGM ? (nM - fm) : WGM;
        u.pm = fm + ((wgid % nig) % gsz); u.pn = (wgid % nig) / gsz; return true;
    }
};
struct EpiBf16 {
    static constexpr bool PERM = true;
    bf16_t* O; int ldc;
    __device__ __forceinline__ void operator()(const f32x4 (&acc)[2][2][4][2], const Unit& u, int wr, int wc, int fr, int fq) const {
        const int row0 = u.pm * BM + wr * 64 + fr, col0 = u.pn * BM + wc * 32 + 8 * fq;
#pragma unroll
        for (int ai = 0; ai < 2; ++ai)
#pragma unroll
            for (int m = 0; m < 4; ++m) { bf16_t* rowp = O + (size_t)(row0 + ai * HALF + m * 16) * ldc + col0;
#pragma unroll
                for (int bj = 0; bj < 2; ++bj) { const f32x4 v0 = acc[ai][bj][m][0], v1 = acc[ai][bj][m][1];
                    u32x4 w; w.x = pk2(v0[0], v0[1]); w.y = pk2(v0[2], v0[3]); w.z = pk2(v1[0], v1[1]); w.w = pk2(v1[2], v1[3]);
                    *(u32x4*)(rowp + bj * HALF) = w; } }
    }
};
template <int ACT  > struct EpiGated {
    static constexpr bool PERM = true;
    bf16_t* O; int ldc;
    __device__ __forceinline__ void operator()(const f32x4 (&acc)[2][2][4][2], const Unit& u, int wr, int wc, int fr, int fq) const {
        const int row0 = u.pm * BM + wr * 64 + fr, col0 = u.pn * HALF + wc * 32 + 8 * fq;
#pragma unroll
        for (int ai = 0; ai < 2; ++ai)
#pragma unroll
            for (int m = 0; m < 4; ++m) { bf16_t* rowp = O + (size_t)(row0 + ai * HALF + m * 16) * ldc + col0;
                float h[8];
#pragma unroll
                for (int n = 0; n < 2; ++n)
#pragma unroll
                    for (int j = 0; j < 4; ++j) { const float g = acc[ai][0][m][n][j], up = acc[ai][1][m][n][j]; const float s = __builtin_amdgcn_rcpf(1.0f + __expf(-g)); h[n * 4 + j] = (ACT == 0 ? g * s : s) * up; }
                u32x4 w; w.x = pk2(h[0], h[1]); w.y = pk2(h[2], h[3]); w.z = pk2(h[4], h[5]); w.w = pk2(h[6], h[7]);
                *(u32x4*)rowp = w; }
    }
};
struct EpiResid {
    static constexpr bool PERM = false;
    const float* resid; float* out; const bf16_t* ple; float s;
    __device__ __forceinline__ void operator()(const f32x4 (&acc)[2][2][4][2], const Unit& u, int wr, int wc, int fr, int fq) const {
        const int col0 = u.pn * BM + wc * 32 + 4 * fq;
#pragma unroll
        for (int ai = 0; ai < 2; ++ai)
#pragma unroll
            for (int m = 0; m < 4; ++m) { const size_t off = (size_t)(u.pm * BM + ai * HALF + wr * 64 + m * 16 + fr) * DM + col0;
#pragma unroll
                for (int bj = 0; bj < 2; ++bj)
#pragma unroll
                    for (int n = 0; n < 2; ++n) { const size_t o2 = off + bj * HALF + n * 16; const f32x4 x = *(const f32x4*)(resid + o2); f32x4 o = x * ALPHA + acc[ai][bj][m][n] * s;
                        if (ple) { const bf16x4 pv = *(const bf16x4*)(ple + o2); o = o + unpack4(pv); }
                        *(f32x4*)(out + o2) = o; } }
    }
};

template <bool HAS_PLE> struct EpiResidLN {
    static constexpr bool PERM = false;
    const float* resid; float* out; bf16_t* xb; const bf16_t* ple; const float* pin; float s;
    const float* g; const float* b; unsigned long long* xbuf; unsigned* cnt; LAS unsigned char* lds;
    __device__ __forceinline__ void operator()(f32x4 (&acc)[2][2][4][2], const Unit& u, int wr, int wc, int fr0, int fq0) const {
        typedef float f32x2v __attribute__((ext_vector_type(2)));
        int fr = fr0, fq = fq0; asm volatile("" : "+v"(fr), "+v"(fq));
        LAS f32x2v* P = (LAS f32x2v*)lds;
        LAS f32x2v* S = (LAS f32x2v*)(lds + 8192);
        const int wid = wr * 4 + wc, lane = fq * 16 + fr;
        const int col0 = u.pn * BM + wc * 32 + 4 * fq;
#pragma unroll
        for (int ai = 0; ai < 2; ++ai)
#pragma unroll
            for (int m = 0; m < 4; ++m) { f32x4 rv[2][2]; bf16x4 pv[2][2]; const size_t off = (size_t)(u.pm * BM + ai * HALF + wr * 64 + m * 16 + fr) * DM + col0;
#pragma unroll
                for (int bj = 0; bj < 2; ++bj)
#pragma unroll
                    for (int n = 0; n < 2; ++n) { const size_t o2 = off + bj * HALF + n * 16; rv[bj][n] = *(const f32x4*)(resid + o2); if (HAS_PLE) pv[bj][n] = *(const bf16x4*)(ple + o2); }
#pragma unroll
                for (int bj = 0; bj < 2; ++bj)
#pragma unroll
                    for (int n = 0; n < 2; ++n) { f32x4 o = rv[bj][n] * ALPHA + acc[ai][bj][m][n] * s; if (HAS_PLE) o = o + unpack4(pv[bj][n]); acc[ai][bj][m][n] = o; }
                asm volatile("" : "+v"(acc[ai][0][m][0]), "+v"(acc[ai][0][m][1]), "+v"(acc[ai][1][m][0]), "+v"(acc[ai][1][m][1]));
                asm volatile("" ::: "memory"); }
#pragma unroll
        for (int ai = 0; ai < 2; ++ai)
#pragma unroll
            for (int m = 0; m < 4; ++m) { float sm = 0.f;
#pragma unroll
                for (int bj = 0; bj < 2; ++bj)
#pragma unroll
                    for (int n = 0; n < 2; ++n) { const f32x4 x = acc[ai][bj][m][n]; sm += (x[0] + x[1]) + (x[2] + x[3]); }
                sm += lane_read(sm, lane ^ 16); sm += lane_read(sm, lane ^ 32);
                const float mw = sm * (1.0f / 64.0f); float qq = 0.f;
#pragma unroll
                for (int bj = 0; bj < 2; ++bj)
#pragma unroll
                    for (int n = 0; n < 2; ++n) { const f32x4 d = acc[ai][bj][m][n] - mw; qq += (d[0] * d[0] + d[1] * d[1]) + (d[2] * d[2] + d[3] * d[3]); }
                qq += lane_read(qq, lane ^ 16); qq += lane_read(qq, lane ^ 32);
                if (fq == 0) P[(ai * HALF + wr * 64 + m * 16 + fr) * 4 + wc] = (f32x2v){mw, qq}; }
        asm volatile("s_waitcnt lgkmcnt(0)\n\ts_barrier" ::: "memory");
        const int row = wid * 32 + (lane & 31);
        if (lane < 32) { const f32x2v a = P[row * 4 + 0], bb = P[row * 4 + 1], c = P[row * 4 + 2], d = P[row * 4 + 3];
            const float mt = (a.x + bb.x + c.x + d.x) * 0.25f; const float da = a.x - mt, db = bb.x - mt, dc = c.x - mt, dd = d.x - mt;
            const float m2 = (a.y + bb.y) + (c.y + d.y) + 64.0f * ((da * da + db * db) + (dc * dc + dd * dd));
            unsigned long long* slot = xbuf + ((size_t)(u.pm * BM + row) * 4 + u.pn);
            __hip_atomic_store(slot, ((unsigned long long)__builtin_bit_cast(unsigned, m2) << 32) | __builtin_bit_cast(unsigned, mt), __ATOMIC_RELAXED, __HIP_MEMORY_SCOPE_AGENT); }
        asm volatile("s_waitcnt vmcnt(0)" ::: "memory");
        if (lane == 0) __hip_atomic_fetch_add(cnt + 64 * u.pm, 1u, __ATOMIC_RELAXED, __HIP_MEMORY_SCOPE_AGENT);
        f32x4 g4v[2][2], b4v[2][2];
#pragma unroll
        for (int bj = 0; bj < 2; ++bj)
#pragma unroll
            for (int n = 0; n < 2; ++n) { const int col = col0 + bj * HALF + n * 16; g4v[bj][n] = *(const f32x4*)(g + col); b4v[bj][n] = *(const f32x4*)(b + col); }
        if (wid == 0) { while ((unsigned)__builtin_amdgcn_readfirstlane(__hip_atomic_load(cnt + 64 * u.pm, __ATOMIC_RELAXED, __HIP_MEMORY_SCOPE_AGENT)) < 32u) __builtin_amdgcn_s_sleep(1);
            __builtin_amdgcn_fence(__ATOMIC_ACQUIRE, "agent"); }
        asm volatile("s_waitcnt vmcnt(0) lgkmcnt(0)\n\ts_barrier" ::: "memory");
        if (lane < 32) { const unsigned long long* slot = xbuf + (size_t)(u.pm * BM + row) * 4; float mt[4], m2[4]; float ms = 0.f;
            unsigned long long w4[4];
#pragma unroll
            for (int t = 0; t < 4; ++t) w4[t] = __hip_atomic_load(slot + t, __ATOMIC_RELAXED, __HIP_MEMORY_SCOPE_AGENT);
            __builtin_amdgcn_sched_barrier(0);
#pragma unroll
            for (int t = 0; t < 4; ++t) { mt[t] = __builtin_bit_cast(float, (unsigned)w4[t]); m2[t] = __builtin_bit_cast(float, (unsigned)(w4[t] >> 32)); ms += mt[t]; }
            const float mean = ms * 0.25f; float qv = 0.f;
#pragma unroll
            for (int t = 0; t < 4; ++t) { const float dm = mt[t] - mean; qv += m2[t] + 256.0f * dm * dm; }
            S[row] = (f32x2v){mean, __builtin_amdgcn_rsqf(qv * (1.0f / 1024.0f) + LN_EPS)}; }
        asm volatile("s_waitcnt vmcnt(0) lgkmcnt(0)\n\ts_barrier" ::: "memory");
#pragma unroll
        for (int bj = 0; bj < 2; ++bj)
#pragma unroll
            for (int n = 0; n < 2; ++n) { const int col = col0 + bj * HALF + n * 16; const f32x4 g4 = g4v[bj][n], b4 = b4v[bj][n];
#pragma unroll
                for (int ai = 0; ai < 2; ++ai)
#pragma unroll
                    for (int m = 0; m < 4; ++m) { const int r = ai * HALF + wr * 64 + m * 16 + fr; const f32x2v sr = S[r]; const size_t grow = (size_t)(u.pm * BM + r);
                        const f32x4 y = (acc[ai][bj][m][n] - sr.x) * sr.y * g4 + b4;
                        *(f32x4*)(out + grow * DM + col) = y; u32x2 w; w.x = pk2(y[0], y[1]); w.y = pk2(y[2], y[3]); *(u32x2*)(xb + grow * XBLD + col) = w; } }
        if (pin) { f32x4 pv8[8];
#pragma unroll
            for (int i = 0; i < 8; ++i) { const int idx = wid * 64 + lane + 512 * i, rr = idx >> 4, c4 = idx & 15; pv8[i] = *(const f32x4*)(pin + (size_t)(u.pm * BM + rr) * 256 + 64 * u.pn + 4 * c4); }
#pragma unroll
            for (int i = 0; i < 8; ++i) { const int idx = wid * 64 + lane + 512 * i, rr = idx >> 4, c4 = idx & 15; const f32x4 pv = pv8[i];
                u32x2 w; w.x = pk2(pv[0], pv[1]); w.y = pk2(pv[2], pv[3]); *(u32x2*)(xb + (size_t)(u.pm * BM + rr) * XBLD + 1024 + 64 * u.pn + 4 * c4) = w; } }
    }
};

template <int LDA, int LDB, int KK, class Epi, int SPLIT_T = 0>
__device__ __forceinline__ void gemm_phase(LAS unsigned char* lds, const int tid, const Gemm g, const StaticOrder& S, const Epi& E) {
    const int  wid = __builtin_amdgcn_readfirstlane(tid >> 6), lane = tid & 63, wr = wid >> 2, wc = wid & 3, fr = lane & 15, fq = lane >> 4;
    constexpr int nt = KK / BK;
    unsigned voffA[2], voffB[2];
#pragma unroll
    for (int i = 0; i < 2; ++i) { int R, C; stage_rc(tid * 16 + i * 8192, R, C); const int Rb = Epi::PERM ? ((R & ~31) + perm32(R & 31)) : R;
        voffA[i] = (unsigned)(R * LDA + C) * 2u; voffB[i] = (unsigned)(Rb * LDB + C) * 2u; }
    constexpr size_t kstep = (size_t)(BK * 2);
    constexpr size_t hstepA = (size_t)HALF * LDA * 2, hstepB = (size_t)HALF * LDB * 2;
    constexpr size_t tstepA = 2 * hstepA, tstepB = 2 * hstepB;
    const unsigned ldsw = (unsigned)wid * 1024u;
    const int aoff = lds_byte(wr * 64 + fr, fq * 8), boff = lds_byte(wc * 32 + fr, fq * 8);
#define PG8_SA(b, h) (((b) * 2 + (h)) * HTB)
#define PG8_SB(b, h) ((4 + (b) * 2 + (h)) * HTB)
#define PG8_STAGE(bufoff, gbase, voff) do { _Pragma("unroll") for (int _i = 0; _i < 2; ++_i) \
        __builtin_amdgcn_global_load_lds((const unsigned*)((const char*)(gbase) + (voff)[_i]), (LAS unsigned*)(lds + (bufoff) + ldsw + _i * 8192), 16, 0, 0); } while (0)
#define PG8_LDA(dst, b, h) do { _Pragma("unroll") for (int m = 0; m < 4; ++m) _Pragma("unroll") for (int k = 0; k < 2; ++k) dst[m][k] = *(const LAS bf16x8*)(lds + PG8_SA(b, h) + aoff + m * 2048 + k * 1024); } while (0)
#define PG8_LDB(dst, b, h) do { _Pragma("unroll") for (int n = 0; n < 2; ++n) _Pragma("unroll") for (int k = 0; k < 2; ++k) dst[n][k] = *(const LAS bf16x8*)(lds + PG8_SB(b, h) + boff + n * 2048 + k * 1024); } while (0)
#define PG8_MMA(ai, bj, At, Bt) do { __builtin_amdgcn_s_setprio(1); _Pragma("unroll") for (int m = 0; m < 4; ++m) _Pragma("unroll") for (int n = 0; n < 2; ++n) _Pragma("unroll") for (int k = 0; k < 2; ++k) \
        acc[ai][bj][m][n] = __builtin_amdgcn_mfma_f32_16x16x32_bf16(Bt[n][k], At[m][k], acc[ai][bj][m][n], 0, 0, 0); __builtin_amdgcn_s_setprio(0); } while (0)
#define PG8_WAIT_V(n) asm volatile("s_waitcnt vmcnt(" #n ")" ::: "memory")
#define PG8_WAIT_L(n) asm volatile("s_waitcnt lgkmcnt(" #n ")" ::: "memory")
#define PG8_BAR __builtin_amdgcn_s_barrier()
#define PG8_SCHED __builtin_amdgcn_sched_barrier(0)
    Unit cur, nxt; int ui = 0;
    if (!S.next(0, cur)) return;
    f32x4 acc[2][2][4][2];
#pragma unroll
    for (int a = 0; a < 2; ++a)
#pragma unroll
        for (int b = 0; b < 2; ++b)
#pragma unroll
            for (int m = 0; m < 4; ++m)
#pragma unroll
                for (int n = 0; n < 2; ++n) acc[a][b][m][n] = (f32x4){0.f, 0.f, 0.f, 0.f};
    bf16x8 At[4][2], B0[2][2], B1[2][2];
    const char* cA = (const char*)g.A + (size_t)cur.pm * tstepA; const char* cB = (const char*)g.Bt + (size_t)cur.pn * tstepB;
    PG8_STAGE(PG8_SB(0, 0), cB, voffB); PG8_STAGE(PG8_SB(0, 1), cB + hstepB, voffB); PG8_STAGE(PG8_SA(0, 0), cA, voffA); PG8_STAGE(PG8_SA(0, 1), cA + hstepA, voffA);
    if (wr == 1) PG8_BAR;
    PG8_WAIT_V(2); PG8_BAR;
    PG8_STAGE(PG8_SB(1, 0), cB + kstep, voffB); PG8_STAGE(PG8_SA(1, 0), cA + kstep, voffA); PG8_STAGE(PG8_SB(1, 1), cB + hstepB + kstep, voffB);
    PG8_WAIT_V(6); PG8_BAR;
    for (;;) {
        const bool has_next = S.next(ui + 1, nxt);
        const char* nA = has_next ? (const char*)g.A + (size_t)nxt.pm * tstepA : cA; const char* nB = has_next ? (const char*)g.Bt + (size_t)nxt.pn * tstepB : cB;
        for (int t = 0; t < nt; t += 2) {
            const bool last = (t == nt - 2);
            const char* a1 = cA + (size_t)(t + 1) * kstep;
            const char* a2 = last ? nA : cA + (size_t)(t + 2) * kstep; const char* b2 = last ? nB : cB + (size_t)(t + 2) * kstep;
            const char* a3 = a2 + kstep; const char* b3 = b2 + kstep;
            PG8_LDB(B0, 0, 0); PG8_LDB(B1, 0, 1); PG8_SCHED; PG8_LDA(At, 0, 0); PG8_STAGE(PG8_SA(1, 1), a1 + hstepA, voffA);
            PG8_WAIT_V(8); PG8_WAIT_L(0); PG8_BAR; if (SPLIT_T == 0 || t < SPLIT_T) PG8_MMA(0, 0, At, B0); if (SPLIT_T == 0 || t >= SPLIT_T) PG8_MMA(0, 1, At, B1); PG8_BAR; PG8_SCHED;
            PG8_LDA(At, 0, 1); PG8_STAGE(PG8_SB(0, 0), b2, voffB); PG8_STAGE(PG8_SB(0, 1), b2 + hstepB, voffB); PG8_STAGE(PG8_SA(0, 0), a2, voffA);
            PG8_WAIT_V(8); PG8_WAIT_L(0); PG8_BAR; if (SPLIT_T == 0 || t < SPLIT_T) PG8_MMA(1, 0, At, B0); if (SPLIT_T == 0 || t >= SPLIT_T) PG8_MMA(1, 1, At, B1); PG8_BAR; PG8_SCHED;
            PG8_LDB(B0, 1, 0); PG8_LDB(B1, 1, 1); PG8_SCHED; PG8_LDA(At, 1, 0); PG8_STAGE(PG8_SA(0, 1), a2 + hstepA, voffA);
            PG8_WAIT_V(8); PG8_WAIT_L(0); PG8_BAR; if (SPLIT_T == 0 || t < SPLIT_T) PG8_MMA(0, 0, At, B0); if (SPLIT_T == 0 || t >= SPLIT_T) PG8_MMA(0, 1, At, B1); PG8_BAR; PG8_SCHED;
            PG8_LDA(At, 1, 1); PG8_STAGE(PG8_SB(1, 0), b3, voffB); PG8_STAGE(PG8_SB(1, 1), b3 + hstepB, voffB); PG8_STAGE(PG8_SA(1, 0), a3, voffA);
            PG8_WAIT_V(8); PG8_WAIT_L(0); PG8_BAR; if (SPLIT_T == 0 || t < SPLIT_T) PG8_MMA(1, 0, At, B0); if (SPLIT_T == 0 || t >= SPLIT_T) PG8_MMA(1, 1, At, B1); PG8_BAR; PG8_SCHED;
        }
        if (wr == 0) PG8_BAR;
        E(acc, cur, wr, wc, fr, fq);
        if (!has_next) break;
#pragma unroll
        for (int a = 0; a < 2; ++a)
#pragma unroll
            for (int b = 0; b < 2; ++b)
#pragma unroll
                for (int m = 0; m < 4; ++m)
#pragma unroll
                    for (int n = 0; n < 2; ++n) acc[a][b][m][n] = (f32x4){0.f, 0.f, 0.f, 0.f};
        cur = nxt; cA = nA; cB = nB; ++ui;
        if (wr == 1) PG8_BAR;
    }
    PG8_WAIT_V(0);
    PG8_BAR;
#undef PG8_SA
#undef PG8_SB
#undef PG8_STAGE
#undef PG8_LDA
#undef PG8_LDB
#undef PG8_MMA
#undef PG8_WAIT_V
#undef PG8_WAIT_L
#undef PG8_BAR
#undef PG8_SCHED
}
}

struct Frame {
    LAS unsigned char* lds; float* ldsf;
    int tid, lane, wave, G, bid; GAS unsigned char* ws; const CAS struct Args* ap;
};

__device__ __forceinline__ void conv_mat(const Frame& F, const float* W, int K, int N, int Ndst, bf16_t* dst, int ldd, int kofs, int mode) {
    const int gw = F.bid * 8 + F.wave, NGW = F.G * 8;
    const int nblk = Ndst / 8, kblk = K / 64, items = nblk * kblk;
    const int nl = F.lane >> 3, kc = F.lane & 7;
    for (int it = gw; it < items; it += NGW) {
        const int nb = it % nblk, kb = it / nblk; const int n = nb * 8 + nl, k0 = kb * 64 + kc * 8;
        const int nc = n < N ? n : N - 1;
        float v[8];
#pragma unroll
        for (int kk = 0; kk < 8; ++kk) v[kk] = W[(size_t)(k0 + kk) * N + nc];
        const float zf = n < N ? 1.0f : 0.0f;
        const int row = (mode == 0) ? n : ((n >> 7) * 256 + (n & 127) + (mode == 2 ? 128 : 0));
        u32x4 w; w.x = pk2(v[0] * zf, v[1] * zf); w.y = pk2(v[2] * zf, v[3] * zf); w.z = pk2(v[4] * zf, v[5] * zf); w.w = pk2(v[6] * zf, v[7] * zf);
        *(u32x4*)(dst + (size_t)row * ldd + kofs + k0) = w;
    }
}
__device__ __forceinline__ void p_convert_weights(Frame& F, int l, int parts) {
    const int gw = F.bid * 8 + F.wave, NGW = F.G * 8;
    unsigned char* wt = (unsigned char*)(F.ws + WS_WT);
    if (parts & 1) {
    conv_mat(F, ((const float*)(const GAS float*)F.ap->in[5]) + (size_t)l * DM * DFF, DM, DFF, DFF, (bf16_t*)(wt + WT_GU1), DM, 0, 1);
    conv_mat(F, ((const float*)(const GAS float*)F.ap->in[6]) + (size_t)l * DM * DFF, DM, DFF, DFF, (bf16_t*)(wt + WT_GU1), DM, 0, 2);
    conv_mat(F, ((const float*)(const GAS float*)F.ap->in[7]) + (size_t)l * DFF * DM, DFF, DM, DM, (bf16_t*)(wt + WT_D1), DFF, 0, 0);
    conv_mat(F, ((const float*)(const GAS float*)F.ap->in[8]) + (size_t)l * DM * DIN, DM, DIN, DINP, (bf16_t*)(wt + WT_IN), DM, 0, 0);
    conv_mat(F, ((const float*)(const GAS float*)F.ap->in[21]) + (size_t)l * DM * DM, DM, DM, DM, (bf16_t*)(wt + WT_OUT), DM, 0, 0);
    }
    if (parts & 2) {
    conv_mat(F, ((const float*)(const GAS float*)F.ap->in[24]) + (size_t)l * DM * DFF, DM, DFF, DFF, (bf16_t*)(wt + WT_GU2), DM, 0, 1);
    conv_mat(F, ((const float*)(const GAS float*)F.ap->in[25]) + (size_t)l * DM * DFF, DM, DFF, DFF, (bf16_t*)(wt + WT_GU2), DM, 0, 2);
    conv_mat(F, ((const float*)(const GAS float*)F.ap->in[26]) + (size_t)l * DFF * DM, DFF, DM, DM, (bf16_t*)(wt + WT_D2), DFF, 0, 0);
    conv_mat(F, ((const float*)(const GAS float*)F.ap->in[27]) + (size_t)l * DM * DM, DM, DM, DM, (bf16_t*)(wt + WT_PLE), XBLD, 0, 1);
    conv_mat(F, ((const float*)(const GAS float*)F.ap->in[28]) + (size_t)l * 256 * DM, 256, DM, DM, (bf16_t*)(wt + WT_PLE), XBLD, 1024, 2);
    bf16_t* wp = (bf16_t*)(wt + WT_PLE);
    for (int it = gw * 64 + F.lane; it < 2048 * 160; it += NGW * 64) { const int row = it / 160, ch = it % 160; const bool isproj = (row >> 7) & 1; const bool z = isproj ? (ch < 128) : (ch >= 128);
        if (z) *(u32x4*)(wp + (size_t)row * XBLD + ch * 8) = (u32x4){0u, 0u, 0u, 0u}; }
    }
}
__device__ __forceinline__ void p_prologue(Frame& F) {
    const int gw = F.bid * 8 + F.wave, NGW = F.G * 8;
    p_convert_weights(F, 0, 3);
    const float* x = ((const float*)(const GAS float*)F.ap->in[0]);
    for (int m = gw; m < M; m += NGW) { const f32x4* xr = (const f32x4*)(x + (size_t)m * DM) + F.lane; u32x2* o = (u32x2*)(((bf16_t*)((unsigned char*)(F.ws + WS_XB))) + (size_t)m * XBLD) + F.lane;
#pragma unroll
        for (int j = 0; j < 4; ++j) { const f32x4 v = xr[64 * j]; u32x2 w; w.x = pk2(v.x, v.y); w.y = pk2(v.z, v.w); o[64 * j] = w; } }
}
__device__ __forceinline__ void p_layernorm(Frame& F, const float* g, const float* b, const float* pl) {
    const int gw = F.bid * 8 + F.wave, NGW = F.G * 8;
    f32x4 g4[4], b4[4];
#pragma unroll
    for (int j = 0; j < 4; ++j) { g4[j] = ((const f32x4*)g)[F.lane + 64 * j]; b4[j] = ((const f32x4*)b)[F.lane + 64 * j]; }
    for (int m = gw; m < M; m += NGW) {
        f32x4* xr = (f32x4*)(((float*)(GAS float*)F.ap->out) + (size_t)m * DM) + F.lane;
        f32x4 v[4]; float s = 0.f;
#pragma unroll
        for (int j = 0; j < 4; ++j) { v[j] = xr[64 * j]; s += (v[j].x + v[j].y) + (v[j].z + v[j].w); }
        const float mean = wave_sum(s) * (1.f / DM); float s2 = 0.f;
#pragma unroll
        for (int j = 0; j < 4; ++j) { v[j] = v[j] - mean; s2 += (v[j].x * v[j].x + v[j].y * v[j].y) + (v[j].z * v[j].z + v[j].w * v[j].w); }
        const float rstd = __builtin_amdgcn_rsqf(wave_sum(s2) * (1.f / DM) + LN_EPS);
        u32x2* o = (u32x2*)(((bf16_t*)((unsigned char*)(F.ws + WS_XB))) + (size_t)m * XBLD) + F.lane;
#pragma unroll
        for (int j = 0; j < 4; ++j) { const f32x4 y = v[j] * rstd * g4[j] + b4[j]; xr[64 * j] = y; u32x2 w; w.x = pk2(y.x, y.y); w.y = pk2(y.z, y.w); o[64 * j] = w; }
        if (pl) { const f32x4 pv = ((const f32x4*)(pl + (size_t)m * 256))[F.lane]; u32x2 w; w.x = pk2(pv.x, pv.y); w.y = pk2(pv.z, pv.w); o[256] = w; }
    }
}

#define LBAR() asm volatile("s_waitcnt lgkmcnt(0)\n\ts_barrier" ::: "memory")
constexpr int LS = 68;
__device__ __forceinline__ void dot_rows(const float* X, const float* Y, int iw, int j, float (&acc)[8]) {
#pragma unroll
    for (int ii = 0; ii < 8; ++ii) acc[ii] = 0.f;
#pragma unroll 4
    for (int d4 = 0; d4 < 16; ++d4) { const f32x4 y = *(const f32x4*)(Y + j * LS + 4 * d4);
#pragma unroll
        for (int ii = 0; ii < 8; ++ii) { const f32x4 x = *(const f32x4*)(X + (iw + 8 * ii) * LS + 4 * d4); acc[ii] += (x.x * y.x + x.y * y.y) + (x.z * y.z + x.w * y.w); } }
}

constexpr int RP = 144;
__device__ __forceinline__ f32x4 tile_xyT(const float* X, const float* Y, int mt, int nt, int lane) {
    const int l15 = lane & 15, q = lane >> 4; f32x4 acc = {0.f, 0.f, 0.f, 0.f};
    const float* xa = X + (16 * mt + l15) * LS + 8 * q; const float* yb = Y + (16 * nt + l15) * LS + 8 * q;
    f32x4 xr[4], yr[4];
#pragma unroll
    for (int k = 0; k < 4; ++k) { xr[k] = *(const f32x4*)(xa + 32 * (k >> 1) + 4 * (k & 1)); yr[k] = *(const f32x4*)(yb + 32 * (k >> 1) + 4 * (k & 1)); }
    __builtin_amdgcn_sched_barrier(0);
#pragma unroll
    for (int ks = 0; ks < 2; ++ks) acc = __builtin_amdgcn_mfma_f32_16x16x32_bf16(pack8(xr[2 * ks], xr[2 * ks + 1]), pack8(yr[2 * ks], yr[2 * ks + 1]), acc, 0, 0, 0);
    return acc;
}
__device__ __forceinline__ void gdn_par_unit(Frame& F, int l, int b, int n, int h, int ul) {
    float* Q = F.ldsf; float* Kx = Q + 64 * LS; float* V = Kx + 64 * LS; float* A = V + 64 * LS; float* vec = A + 64 * LS;
    unsigned char* RAW = (unsigned char*)(vec + 320);
    bf16_t* STG = (bf16_t*)((unsigned char*)F.ldsf + 104704);
    int tid = F.tid; asm volatile("" : "+v"(tid));
    const bf16_t* hin = ((bf16_t*)(F.ws + WS_BIG)) + (size_t)b * SEQL * DINP;
    const float* cw = ((const float*)(const GAS float*)F.ap->in[17]) + (size_t)l * 4 * 1152;
    unsigned char* SCRB = (unsigned char*)(F.ws + WS_XB);
    u32x4* GW = (u32x4*)(SCRB + SC_GW) + (size_t)ul * 512; u32x4* GQK = (u32x4*)(SCRB + SC_GQK) + (size_t)ul * 512; u32x4* GQ = (u32x4*)(SCRB + SC_GQ) + (size_t)ul * 512;
    u32x4* GKT = (u32x4*)(SCRB + SC_GKT) + (size_t)ul * 512; u32x4* GU = (u32x4*)(SCRB + SC_GU) + (size_t)ul * 512; float* GV = (float*)(SCRB + SC_GVEC) + (size_t)ul * 256;
    { u32x4 r[4];
#pragma unroll
      for (int i = 0; i < 4; ++i) { const int p = tid + 512 * i, tsr = p / 536, rem = p - tsr * 536, row = rem >> 3, ch = rem & 7; const int tr = n * 64 - 3 + row;
          r[i] = (u32x4){0u, 0u, 0u, 0u};
          if (p < 1608 && tr >= 0) r[i] = *(const u32x4*)(hin + (size_t)tr * DINP + C_GQ + tsr * 384 + h * 64 + ch * 8); }
#pragma unroll
      for (int i = 0; i < 4; ++i) { const int p = tid + 512 * i, tsr = p / 536, rem = p - tsr * 536, row = rem >> 3, ch = rem & 7;
          if (p < 1608) *(u32x4*)(RAW + (tsr * 67 + row) * RP + ch * 16) = r[i]; } }
    float ag = 0.f, bg = 0.f;
    if (tid < 64) { const size_t ro = (size_t)(n * 64 + tid) * DINP; ag = bf2f(hin[ro + C_GA + h]); bg = bf2f(hin[ro + C_GB + h]); }
    const float dtb_ = ((const float*)(const GAS float*)F.ap->in[19])[l * 6 + h], alog_ = ((const float*)(const GAS float*)F.ap->in[18])[l * 6 + h];
    LBAR();
    { const int d = tid & 63;
#pragma unroll
      for (int tsr = 0; tsr < 3; ++tsr) { const int cwi = tsr * 384 + h * 64 + d; const float w0 = cw[cwi], w1 = cw[1152 + cwi], w2 = cw[2 * 1152 + cwi], w3 = cw[3 * 1152 + cwi];
          const unsigned char* rb = RAW + tsr * 67 * RP + d * 2;
          bf16_t xr[8][4];
#pragma unroll
          for (int i = 0; i < 8; ++i)
#pragma unroll
              for (int kk = 0; kk < 4; ++kk) xr[i][kk] = *(const bf16_t*)(rb + ((tid >> 6) + 8 * i + kk) * RP);
          __builtin_amdgcn_sched_barrier(0);
#pragma unroll
          for (int i = 0; i < 8; ++i) { const int t = (tid >> 6) + 8 * i;
              const float sacc = (w0 * bf2f(xr[i][0]) + w1 * bf2f(xr[i][1])) + (w2 * bf2f(xr[i][2]) + w3 * bf2f(xr[i][3]));
              F.ldsf[tsr * 64 * LS + t * LS + d] = siluf_(sacc); }
          __builtin_amdgcn_sched_barrier(0); } }
    LBAR();
    { const int r = tid >> 2, part = tid & 3; float* p = F.ldsf + (r >> 6) * 64 * LS + (r & 63) * LS + part * 16; float ss = 0.f;
#pragma unroll
      for (int i = 0; i < 16; ++i) ss += p[i] * p[i];
      ss = quad_sum(ss);
      const float sc = __builtin_amdgcn_rsqf(ss + 1e-6f) * (r < 64 ? 0.125f : 1.0f);
#pragma unroll
      for (int i = 0; i < 16; ++i) p[i] *= sc; }
    if (tid < 64) { const float xs = ag + dtb_; const float sp = xs > 20.f ? xs : log1p_pos(__expf(xs));
        float v = -__expf(alog_) * sp; vec[tid] = v; vec[64 + tid] = sigmoidf_(bg);
#pragma unroll
        for (int o = 1; o < 64; o <<= 1) { const float u = lane_read(v, (tid - o) & 63); if (tid >= o) v += u; }
        const float gl = __builtin_bit_cast(float, __builtin_amdgcn_readlane(__builtin_bit_cast(int, v), 63)); const float eg = __expf(v), et = __expf(gl - v);
        vec[128 + tid] = v; vec[192 + tid] = eg; vec[256 + tid] = et; GV[tid] = eg; GV[64 + tid] = et; }
    LBAR();
    { const int mt = F.wave >> 1, l15 = F.lane & 15, q = F.lane >> 4;
      const f32x4 gci4 = *(const f32x4*)(vec + 128 + 16 * mt + 4 * q), bi4 = *(const f32x4*)(vec + 64 + 16 * mt + 4 * q);
      const float gcj0 = vec[128 + 32 * (F.wave & 1) + l15], gcj1 = vec[128 + 32 * (F.wave & 1) + 16 + l15];
#pragma unroll
      for (int t2 = 0; t2 < 2; ++t2) { const int nt = 2 * (F.wave & 1) + t2; const int j = 16 * nt + l15;
          f32x4 kkv = {0.f, 0.f, 0.f, 0.f}, qkv = {0.f, 0.f, 0.f, 0.f};
          if (nt <= mt) { kkv = tile_xyT(Kx, Kx, mt, nt, F.lane); qkv = tile_xyT(Q, Kx, mt, nt, F.lane); }
          const float gcj = t2 ? gcj1 : gcj0;
#pragma unroll
          for (int jj = 0; jj < 4; ++jj) { const int i = 16 * mt + 4 * q + jj; const float dec = (j <= i) ? __expf(fminf(gci4[jj] - gcj, 0.f)) : 0.f;
              A[i * LS + j] = (j < i) ? bi4[jj] * kkv[jj] * dec : 0.f;
              STG[frag_off(i, j)] = (bf16_t)f2bf(qkv[jj] * dec); } } }
    { float fv[16], fs[16];
#pragma unroll
      for (int i = 0; i < 16; ++i) { const int which = i >> 3, rem = tid + 512 * (i & 7), cc = rem >> 6, r = rem & 63;
          fv[i] = F.ldsf[which * 64 * LS + cc * LS + r]; fs[i] = vec[192 + 64 * which + cc]; }
      __builtin_amdgcn_sched_barrier(0);
#pragma unroll
      for (int i = 0; i < 16; ++i) fv[i] *= fs[i];
#pragma unroll
      for (int i = 0; i < 16; ++i) { const int which = i >> 3, rem = tid + 512 * (i & 7), cc = rem >> 6, r = rem & 63;
          if (which == 0) STG[4096 + frag_off(cc, r)] = (bf16_t)f2bf(fv[i]);
          else STG[8192 + frag_off(r, cc)] = (bf16_t)f2bf(fv[i]); } }
    LBAR();
    { const u32x4* sg = (const u32x4*)STG; GQK[tid] = sg[tid]; GQ[tid] = sg[512 + tid]; GKT[tid] = sg[1024 + tid]; }
    { constexpr int XL = 132; float* XS = vec + 320;
      { float xv[16];
        const bool isU = (F.wave & 1) == 0;
        const float* src0 = (isU ? V : Kx) + (tid & 63);
        float xb[16], xe[16];
#pragma unroll
        for (int i = 0; i < 16; ++i) { const int r = (tid >> 7) + 4 * i; xv[i] = src0[r * LS]; xb[i] = vec[64 + r]; xe[i] = vec[192 + r]; }
        __builtin_amdgcn_sched_barrier(0);
#pragma unroll
        for (int i = 0; i < 16; ++i) xv[i] = xv[i] * xb[i] * (isU ? 1.0f : xe[i]);
#pragma unroll
        for (int i = 0; i < 16; ++i) { const int idx = tid + 512 * i, r = idx >> 7, c = idx & 127; XS[r * XL + c] = xv[i]; } }
      LBAR();
      { const int c = tid >> 2, k = tid & 3;
#pragma unroll 1
        for (int ib = 0; ib < 4; ++ib) { float xk[4];
#pragma unroll
            for (int i = 0; i < 4; ++i) xk[i] = XS[(16 * ib + 4 * i + k) * XL + c];
            if (ib > 0) { float s0 = 0.f, s1 = 0.f, s2 = 0.f, s3 = 0.f; const float* Ar = A + (16 * ib + k) * LS;
#pragma unroll 2
                for (int j = 0; j < 16 * ib; j += 4) { const float x0 = XS[j * XL + c], x1 = XS[(j + 1) * XL + c], x2 = XS[(j + 2) * XL + c], x3 = XS[(j + 3) * XL + c];
                    const f32x4 a0 = *(const f32x4*)(Ar + j), a1 = *(const f32x4*)(Ar + 4 * LS + j), a2 = *(const f32x4*)(Ar + 8 * LS + j), a3 = *(const f32x4*)(Ar + 12 * LS + j);
                    s0 += (a0.x * x0 + a0.y * x1) + (a0.z * x2 + a0.w * x3); s1 += (a1.x * x0 + a1.y * x1) + (a1.z * x2 + a1.w * x3);
                    s2 += (a2.x * x0 + a2.y * x1) + (a2.z * x2 + a2.w * x3); s3 += (a3.x * x0 + a3.y * x1) + (a3.z * x2 + a3.w * x3); }
                xk[0] -= s0; xk[1] -= s1; xk[2] -= s2; xk[3] -= s3; }
            const float* Ab = A + (16 * ib) * LS + 16 * ib + k;
            float av[16][4];
#pragma unroll
            for (int r = 1; r < 16; ++r)
#pragma unroll
                for (int j4 = 0; j4 <= ((r - 1) >> 2); ++j4) av[r][j4] = Ab[r * LS + 4 * j4];
            __builtin_amdgcn_sched_barrier(0);
#pragma unroll
            for (int r = 1; r < 16; ++r) { float part = 0.f;
#pragma unroll
                for (int j4 = 0; j4 <= ((r - 1) >> 2); ++j4) part += av[r][j4] * xk[j4];
                const float tot = quad_sum(part);
                if (k == (r & 3)) xk[r >> 2] -= tot; }
#pragma unroll
            for (int i = 0; i < 4; ++i) XS[(16 * ib + 4 * i + k) * XL + c] = xk[i];
            asm volatile("s_waitcnt lgkmcnt(0)" ::: "memory"); } }
      LBAR();
      bf16_t* ST2 = (bf16_t*)Q;
      { float xv[16];
#pragma unroll
        for (int i = 0; i < 16; ++i) { const int idx = tid + 512 * i, r = idx >> 7, c = idx & 127; xv[i] = XS[r * XL + c]; }
        __builtin_amdgcn_sched_barrier(0);
#pragma unroll
        for (int i = 0; i < 16; ++i) { const int r = (tid >> 7) + 4 * i, cc = tid & 63; const bf16_t v = (bf16_t)f2bf(xv[i]);
            if ((F.wave & 1) == 0) ST2[cfrag_off(r, cc)] = v; else ST2[4096 + frag_off(r, cc)] = v; } }
      LBAR();
      { const u32x4* sg = (const u32x4*)ST2; GU[tid] = sg[tid]; GW[tid] = sg[512 + tid]; }
    }
    LBAR();
}

__device__ __forceinline__ void ret_par_unit(Frame& F, int l, int b, int n, int h, int ul) {
    float* Q = F.ldsf; float* Kx = Q + 64 * LS; float* V = Kx + 64 * LS; float* gp = V + 64 * LS;
    unsigned char* RAW = (unsigned char*)F.ldsf + 53248;
    bf16_t* STG = (bf16_t*)((unsigned char*)F.ldsf + 80896);
    int tid = F.tid; asm volatile("" : "+v"(tid));
    const bf16_t* hin = ((bf16_t*)(F.ws + WS_BIG)) + (size_t)b * SEQL * DINP;
    const int* pos = (const int*)(const GAS int*)F.ap->in[2] + (size_t)b * SEQL + n * 64;
    unsigned char* SCRB = (unsigned char*)(F.ws + WS_XB);
    u32x4* GSC = (u32x4*)(SCRB + SC_RSC) + (size_t)ul * 512; u32x4* GQX = (u32x4*)(SCRB + SC_RQX) + (size_t)ul * 512;
    u32x4* GKT = (u32x4*)(SCRB + SC_RKT) + (size_t)ul * 512; u32x4* GVT = (u32x4*)(SCRB + SC_RVT) + (size_t)ul * 512;
    const float lg = (h == 0) ? -0.031748698314580f : (h == 1) ? -0.015748356968139f : (h == 2) ? -0.007843177461025f : -0.003913899321136f;
    if (tid < 65) gp[tid] = __expf((float)tid * lg);
    int posv[4];
#pragma unroll
    for (int k = 0; k < 4; ++k) posv[k] = pos[(tid >> 5) + 16 * k];
    { u32x4 r[3];
#pragma unroll
      for (int i = 0; i < 3; ++i) { const int p = tid + 512 * i, tsr = p >> 9, rem = p & 511, row = rem >> 3, ch = rem & 7;
          r[i] = *(const u32x4*)(hin + (size_t)(n * 64 + row) * DINP + tsr * 256 + h * 64 + ch * 8); }
#pragma unroll
      for (int i = 0; i < 3; ++i) { const int p = tid + 512 * i, tsr = p >> 9, rem = p & 511, row = rem >> 3, ch = rem & 7; *(u32x4*)(RAW + (tsr * 64 + row) * RP + ch * 16) = r[i]; } }
    LBAR();
    { bf16_t xa[8], xb2[8], vr[8];
      const int i = tid & 31;
#pragma unroll
      for (int it = 0; it < 8; ++it) { const int tsr = it >> 2, t = (tid >> 5) + 16 * (it & 3); const unsigned char* rb = RAW + (tsr * 64 + t) * RP; xa[it] = *(const bf16_t*)(rb + i * 2); xb2[it] = *(const bf16_t*)(rb + (i + 32) * 2); }
#pragma unroll
      for (int it = 0; it < 8; ++it) { const int idx = tid + 512 * it, t = idx >> 6, d = idx & 63; vr[it] = *(const bf16_t*)(RAW + (128 + t) * RP + d * 2); }
      __builtin_amdgcn_sched_barrier(0);
      const double invf = INVF_REV[i];
#pragma unroll
      for (int it = 0; it < 8; ++it) { const int tsr = it >> 2, t = (tid >> 5) + 16 * (it & 3);
          const float x1 = bf2f(xa[it]), x2 = bf2f(xb2[it]);
          const double rev = (double)posv[it & 3] * invf; const float fr = (float)(rev - __builtin_rint(rev));
          const float cs = __builtin_amdgcn_cosf(fr), sn = __builtin_amdgcn_sinf(fr); const float sc = tsr ? 1.0f : 0.125f;
          float* dst = F.ldsf + tsr * 64 * LS + t * LS; dst[i] = (x1 * cs - x2 * sn) * sc; dst[i + 32] = (x2 * cs + x1 * sn) * sc; }
#pragma unroll
      for (int it = 0; it < 8; ++it) { const int idx = tid + 512 * it, t = idx >> 6, d = idx & 63; V[t * LS + d] = bf2f(vr[it]); } }
    LBAR();
    { const int mt = F.wave >> 1, l15 = F.lane & 15, q = F.lane >> 4;
#pragma unroll
      for (int t2 = 0; t2 < 2; ++t2) { const int nt = 2 * (F.wave & 1) + t2; const int j = 16 * nt + l15; const f32x4 sc = tile_xyT(Q, Kx, mt, nt, F.lane);
#pragma unroll
          for (int jj = 0; jj < 4; ++jj) { const int i = 16 * mt + 4 * q + jj; const int dd = i > j ? i - j : j - i; STG[frag_off(i, j)] = (bf16_t)f2bf(sc[jj] * gp[dd]); } } }
    { float fv[24], fs[24];
#pragma unroll
      for (int i = 0; i < 24; ++i) { const int which = i >> 3, rem = tid + 512 * (i & 7), cc = rem >> 6, r = rem & 63;
          fs[i] = (which == 0) ? gp[cc + 1] : (which == 1) ? gp[63 - cc] : 1.0f; fv[i] = F.ldsf[which * 64 * LS + cc * LS + r]; }
      __builtin_amdgcn_sched_barrier(0);
#pragma unroll
      for (int i = 0; i < 24; ++i) fv[i] *= fs[i];
#pragma unroll
      for (int i = 0; i < 24; ++i) { const int which = i >> 3, rem = tid + 512 * (i & 7), cc = rem >> 6, r = rem & 63;     const bf16_t v = (bf16_t)f2bf(fv[i]);
          if (which == 0) STG[4096 + frag_off(cc, r)] = v; else if (which == 1) STG[8192 + frag_off(r, cc)] = v; else STG[12288 + bfrag_off(cc, r)] = v; } }
    LBAR();
    { const u32x4* sg = (const u32x4*)STG; GSC[tid] = sg[tid]; GQX[tid] = sg[512 + tid]; GKT[tid] = sg[1024 + tid]; GVT[tid] = sg[1536 + tid]; }
    LBAR();
}

constexpr int LP = 65;
__device__ __forceinline__ void lru_par_unit(Frame& F, int l, int b, int n, int g) {
    float* XC = F.ldsf; float* WA = XC + 64 * LS; float* WX = WA + 64 * LS; float* AA = WX + 64 * LS; float* BB = AA + 64 * LP;
    int tid = F.tid; asm volatile("" : "+v"(tid));
    const bf16_t* hin = ((bf16_t*)(F.ws + WS_BIG)) + (size_t)b * SEQL * DINP;
    const float* wa = ((const float*)(const GAS float*)F.ap->in[12]) + (size_t)(l * 6 + g) * 4096; const float* wx = ((const float*)(const GAS float*)F.ap->in[14]) + (size_t)(l * 6 + g) * 4096;
    const float* cw = ((const float*)(const GAS float*)F.ap->in[10]) + (size_t)l * 4 * 384; const float* cb = ((const float*)(const GAS float*)F.ap->in[11]) + (size_t)l * 384;
    float pba[2], pbx[2], plam[2];
#pragma unroll
    for (int t2 = 0; t2 < 2; ++t2) { const int ch = g * 64 + 32 * (F.wave & 1) + 16 * t2 + (F.lane & 15);
        pba[t2] = ((const float*)(const GAS float*)F.ap->in[13])[l * 384 + ch]; pbx[t2] = ((const float*)(const GAS float*)F.ap->in[15])[l * 384 + ch]; plam[t2] = ((const float*)(const GAS float*)F.ap->in[16])[l * 384 + ch]; }
    unsigned char* RAWX = (unsigned char*)F.ldsf + 85504;
    unsigned char* RAWG = RAWX + 67 * RP;
    { f32x4 wv[4]; u32x4 r[3];
#pragma unroll
      for (int i = 0; i < 2; ++i) { wv[i] = ((const f32x4*)wa)[tid + 512 * i]; wv[2 + i] = ((const f32x4*)wx)[tid + 512 * i]; }
#pragma unroll
      for (int i = 0; i < 3; ++i) { const int p = tid + 512 * i; r[i] = (u32x4){0u, 0u, 0u, 0u};
          if (p < 536) { const int row = p >> 3, ch = p & 7, tr = n * 64 - 3 + row; if (tr >= 0) r[i] = *(const u32x4*)(hin + (size_t)tr * DINP + C_LX + g * 64 + ch * 8); }
          else if (p < 1048) { const int q = p - 536, row = q >> 3, ch = q & 7; r[i] = *(const u32x4*)(hin + (size_t)(n * 64 + row) * DINP + C_LG + g * 64 + ch * 8); } }
#pragma unroll
      for (int i = 0; i < 2; ++i) { const int e0 = 4 * (tid + 512 * i), ii = e0 >> 6, j0 = e0 & 63;
#pragma unroll
          for (int k = 0; k < 4; ++k) { WA[(j0 + k) * LS + ii] = wv[i][k]; WX[(j0 + k) * LS + ii] = wv[2 + i][k]; } }
#pragma unroll
      for (int i = 0; i < 3; ++i) { const int p = tid + 512 * i;
          if (p < 536) *(u32x4*)(RAWX + (p >> 3) * RP + (p & 7) * 16) = r[i];
          else if (p < 1048) { const int q = p - 536; *(u32x4*)(RAWG + (q >> 3) * RP + (q & 7) * 16) = r[i]; } } }
    LBAR();
    { const int c = tid & 63, ch = g * 64 + c; const float w0 = cw[ch], w1 = cw[384 + ch], w2 = cw[768 + ch], w3 = cw[1152 + ch], cbv = cb[ch];
      const unsigned char* rb = RAWX + c * 2; bf16_t xr[8][4];
#pragma unroll
      for (int i = 0; i < 8; ++i)
#pragma unroll
          for (int kk = 0; kk < 4; ++kk) xr[i][kk] = *(const bf16_t*)(rb + ((tid >> 6) + 8 * i + kk) * RP);
      __builtin_amdgcn_sched_barrier(0);
#pragma unroll
      for (int i = 0; i < 8; ++i) { const int t = (tid >> 6) + 8 * i;
          XC[t * LS + c] = cbv + ((w0 * bf2f(xr[i][0]) + w1 * bf2f(xr[i][1])) + (w2 * bf2f(xr[i][2]) + w3 * bf2f(xr[i][3]))); } }
    LBAR();
    { const int mt = F.wave >> 1, l15 = F.lane & 15, q = F.lane >> 4;
#pragma unroll
      for (int t2 = 0; t2 < 2; ++t2) { const int nt = 2 * (F.wave & 1) + t2; const int j = 16 * nt + l15, ch = g * 64 + j;
          const f32x4 accA = tile_xyT(XC, WA, mt, nt, F.lane), accX = tile_xyT(XC, WX, mt, nt, F.lane);
          const float ba = pba[t2], bx = pbx[t2], lam = plam[t2];
          const float ls = (-lam > 20.f) ? lam : -log1p_pos(__expf(-lam));
#pragma unroll
          for (int jj = 0; jj < 4; ++jj) { const int t = 16 * mt + 4 * q + jj; const float r = sigmoidf_(accA[jj] + ba), ig = sigmoidf_(accX[jj] + bx);
              const float la = 8.0f * r * ls; const float a = __expf(la); const float bc = __builtin_amdgcn_sqrtf(fmaxf(one_minus_exp(2.0f * la), 0.f)) * (ig * XC[t * LS + j]);
              AA[t * LP + j] = a; BB[t * LP + j] = bc; } } }
    LBAR();
    { const int w = tid >> 6, c = tid & 63; float hl[8], al[8]; float hcur = 0.f, ac = 1.f;
#pragma unroll
      for (int k = 0; k < 8; ++k) { hl[k] = BB[(8 * w + k) * LP + c]; al[k] = AA[(8 * w + k) * LP + c]; }
#pragma unroll
      for (int k = 0; k < 8; ++k) { hcur = al[k] * hcur + hl[k]; ac *= al[k]; hl[k] = hcur; al[k] = ac; }
      float* SEG = (float*)(RAWX);
      SEG[(w * 2) * 64 + c] = hcur; SEG[(w * 2 + 1) * 64 + c] = ac;
      LBAR();
      float ch_ = 0.f, ca_ = 1.f;
#pragma unroll
      for (int j = 0; j < 7; ++j) if (j < w) { const float hj = SEG[(j * 2) * 64 + c], aj = SEG[(j * 2 + 1) * 64 + c]; ch_ = aj * ch_ + hj; ca_ *= aj; }
#pragma unroll
      for (int k = 0; k < 8; ++k) { BB[(8 * w + k) * LP + c] = hl[k] + al[k] * ch_; AA[(8 * w + k) * LP + c] = al[k] * ca_; }
      if (w == 7) { const size_t so = (size_t)(b * 128 + n) * 384 + g * 64 + c; ((float*)(((unsigned char*)(F.ws + WS_XB)) + SC_LSH))[so] = hl[7] + al[7] * ch_; ((float*)(((unsigned char*)(F.ws + WS_XB)) + SC_LSA))[so] = al[7] * ca_; } }
    LBAR();
    bf16_t* P2 = ((bf16_t*)(F.ws + WS_BIG)) + (size_t)b * SEQL * DINP + C_LG;
#pragma unroll 2
    for (int i = 0; i < 8; ++i) { const int idx = tid + 512 * i, t = idx >> 6, c = idx & 63, ch = g * 64 + c, tok = n * 64 + t;
        const float ge = gelu_tanh(bf2f(*(const bf16_t*)(RAWG + t * RP + c * 2)));
        ((bf16_t*)(F.ws + WS_O))[((size_t)b * SEQL + tok) * DM + O_L + ch] = (bf16_t)f2bf(BB[t * LP + c] * ge);
        P2[(size_t)tok * DINP + ch] = (bf16_t)f2bf(AA[t * LP + c] * ge); }
    LBAR();
}

#ifndef PMASK
#define PMASK 7
#endif
#define PSEL(b) ((PMASK & (b)) != 0)
__device__ __forceinline__ void p_mix_par(Frame& F, int l) {
    for (int u = F.bid; u < 16384; u += F.G) {
        if (u < 6144) { const int h = u % 6, n = (u / 6) & 127, b = u / 768; if (PSEL(1)) gdn_par_unit(F, l, b, n, h, u); }
        else if (u < 10240) { const int v = u - 6144; const int h = v & 3, n = (v >> 2) & 127, b = v >> 9; if (PSEL(2)) ret_par_unit(F, l, b, n, h, v); }
        else { const int v = u - 10240; const int g = v % 6, n = (v / 6) & 127, b = v / 768; if (PSEL(4)) lru_par_unit(F, l, b, n, g); }
    }
}

#define MFMA16(a, b, c) __builtin_amdgcn_mfma_f32_16x16x32_bf16((a), (b), (c), 0, 0, 0)
template <bool GDN> __device__ __forceinline__ size_t seq_tile_base(int k) {
    if (GDN) return k == 0 ? SC_GW : k == 1 ? SC_GQ : k == 2 ? SC_GQK : k == 3 ? SC_GKT : SC_GU;
    return k == 0 ? SC_RQX : k == 1 ? SC_RSC : k == 2 ? SC_RKT : SC_RVT;
}
template <bool GDN>
__device__ __forceinline__ void seq_chain(Frame& F, int l, int b, int h) {
    constexpr int NT = GDN ? 5 : 4, NR = 2 * NT + 2;
    constexpr int EOFF = NT * 8192, SLOT = EOFF + 64, RING = 0, OUTB = 2 * SLOT, OUTSZ = 64 * 68 * 4;
    const int w = F.wave, lane = F.lane, q = lane >> 4, l15 = lane & 15;
    LAS unsigned char* const L = F.lds;
    const bf16_t* hin = ((bf16_t*)(F.ws + WS_BIG)) + (size_t)b * SEQL * DINP;
    const int zcol = (GDN ? C_GZ : C_RG) + h * 64;
    const size_t ustride = GDN ? 6 : 4, u0 = (size_t)(b * 128) * ustride + h;
    if (w >= 4) {
        const int lt = F.tid - 256, ch = lt & 7, r0 = lt >> 3;
        float gn[8];
#pragma unroll
        for (int k = 0; k < 8; ++k) gn[k] = GDN ? ((const float*)(const GAS float*)F.ap->in[20])[l * 64 + 8 * ch + k] : ((const float*)(const GAS float*)F.ap->in[9])[l * 256 + h * 64 + 8 * ch + k];
        bf16_t* const obase = ((bf16_t*)(F.ws + WS_O)) + (size_t)b * SEQL * DM + (GDN ? O_G : O_R) + h * 64 + 8 * ch;
        u32x4 R0[2 * NT], R1[2 * NT], R2[2 * NT], Z0[2], Z1[2], Z2[2]; float E0 = 0.f, E1 = 0.f, E2 = 0.f;
#define SEQ_LOAD(R, E, nn) do { if ((nn) < NCH) { const size_t un = u0 + (size_t)(nn) * ustride; \
            _Pragma("unroll") for (int k = 0; k < NT; ++k) { const u32x4* src = (const u32x4*)((unsigned char*)(F.ws + WS_XB) + seq_tile_base<GDN>(k)) + un * 512 + lt; R[2 * k] = src[0]; R[2 * k + 1] = src[256]; } \
            if (GDN) E = ((const float*)((unsigned char*)(F.ws + WS_XB) + SC_GVEC))[un * 256 + 63]; } } while (0)
#define SEQ_LOADZ(Z, nn) do { if ((nn) < NCH) { _Pragma("unroll") for (int i = 0; i < 2; ++i) Z[i] = *(const u32x4*)(hin + (size_t)((nn) * 64 + r0 + 32 * i) * DINP + zcol + ch * 8); } } while (0)
#define SEQ_STORE(R, E, nn) do { LAS unsigned char* sl = L + RING + ((nn) & 1) * SLOT; \
            _Pragma("unroll") for (int k = 0; k < NT; ++k) { *(LAS u32x4*)(sl + k * 8192 + lt * 16) = R[2 * k]; *(LAS u32x4*)(sl + k * 8192 + (lt + 256) * 16) = R[2 * k + 1]; } \
            if (GDN && lt == 0) *(LAS float*)(sl + EOFF) = E; } while (0)
#define SEQ_OUT(ZQ, nn) do { const LAS float* ob = (const LAS float*)(L + OUTB + ((nn) & 1) * OUTSZ); \
            _Pragma("unroll") for (int i = 0; i < 2; ++i) { const int rr = r0 + 32 * i; const f32x4 o0 = *(const LAS f32x4*)(ob + rr * 68 + 8 * ch), o1 = *(const LAS f32x4*)(ob + rr * 68 + 8 * ch + 4); \
                float s2 = ((o0[0] * o0[0] + o0[1] * o0[1]) + (o0[2] * o0[2] + o0[3] * o0[3])) + ((o1[0] * o1[0] + o1[1] * o1[1]) + (o1[2] * o1[2] + o1[3] * o1[3])); \
                float s1 = ((o0[0] + o0[1]) + (o0[2] + o0[3])) + ((o1[0] + o1[1]) + (o1[2] + o1[3])); \
                s2 += __builtin_bit_cast(float, __builtin_amdgcn_update_dpp(0, __builtin_bit_cast(int, s2), 0xB1, 0xF, 0xF, true)); s2 += __builtin_bit_cast(float, __builtin_amdgcn_update_dpp(0, __builtin_bit_cast(int, s2), 0x4E, 0xF, 0xF, true)); \
                s2 += __builtin_bit_cast(float, __builtin_amdgcn_update_dpp(0, __builtin_bit_cast(int, s2), 0x141, 0xF, 0xF, true)); \
                float mu = 0.f, rs; \
                if (GDN) { rs = __builtin_amdgcn_rsqf(s2 * (1.0f / 64.0f) + 1e-6f); } \
                else { s1 += __builtin_bit_cast(float, __builtin_amdgcn_update_dpp(0, __builtin_bit_cast(int, s1), 0xB1, 0xF, 0xF, true)); s1 += __builtin_bit_cast(float, __builtin_amdgcn_update_dpp(0, __builtin_bit_cast(int, s1), 0x4E, 0xF, 0xF, true)); \
                    s1 += __builtin_bit_cast(float, __builtin_amdgcn_update_dpp(0, __builtin_bit_cast(int, s1), 0x141, 0xF, 0xF, true)); \
                    mu = s1 * (1.0f / 64.0f); rs = __builtin_amdgcn_rsqf(fmaxf(s2 * (1.0f / 64.0f) - mu * mu, 0.f) + 1e-5f); } \
                float y[8]; \
                _Pragma("unroll") for (int k = 0; k < 4; ++k) { const unsigned zw = ZQ[i][k]; const float z0 = __builtin_bit_cast(float, zw << 16), z1 = __builtin_bit_cast(float, zw & 0xffff0000u); \
                    const float a0 = (k < 2 ? o0[2 * k] : o1[2 * k - 4]), a1 = (k < 2 ? o0[2 * k + 1] : o1[2 * k - 3]); \
                    y[2 * k] = (a0 - mu) * rs * gn[2 * k] * siluf_(z0); y[2 * k + 1] = (a1 - mu) * rs * gn[2 * k + 1] * siluf_(z1); } \
                u32x4 ov; ov.x = pk2(y[0], y[1]); ov.y = pk2(y[2], y[3]); ov.z = pk2(y[4], y[5]); ov.w = pk2(y[6], y[7]); \
                *(u32x4*)(obase + (size_t)((nn) * 64 + rr) * DM) = ov; } } while (0)
#define SEQ_LITER(R, E, ZQ, nn) do { if ((nn) <= NCH) { if ((nn) < NCH) { SEQ_STORE(R, E, nn); } SEQ_LOAD(R, E, (nn) + 3); LBAR(); \
            if ((nn) > 0) { SEQ_OUT(ZQ, (nn) - 1); } SEQ_LOADZ(ZQ, (nn) + 2); } } while (0)
        SEQ_LOAD(R0, E0, 0); SEQ_LOAD(R1, E1, 1); SEQ_LOAD(R2, E2, 2); SEQ_LOADZ(Z0, 0); SEQ_LOADZ(Z1, 1);
        for (int n = 0; n <= NCH; n += 3) { SEQ_LITER(R0, E0, Z2, n); SEQ_LITER(R1, E1, Z0, n + 1); SEQ_LITER(R2, E2, Z1, n + 2); }
#undef SEQ_LOAD
#undef SEQ_LOADZ
#undef SEQ_STORE
#undef SEQ_OUT
#undef SEQ_LITER
        return;
    }
    const float lgam = (h == 0) ? -0.031748698314580f : (h == 1) ? -0.015748356968139f : (h == 2) ? -0.007843177461025f : -0.003913899321136f;
    const float cd = __expf(64.0f * lgam);
    f32x4 S[4];
#pragma unroll
    for (int i = 0; i < 4; ++i) S[i] = (f32x4){0.f, 0.f, 0.f, 0.f};
    for (int n = 0; n <= NCH; ++n) {
        LBAR();
        if (n == NCH) break;
        LAS unsigned char* sl = L + RING + (n & 1) * SLOT;
        const LAS bf16x8* T0 = (const LAS bf16x8*)(sl) + lane; const LAS bf16x8* T1 = (const LAS bf16x8*)(sl + 8192) + lane;
        const LAS bf16x8* T2 = (const LAS bf16x8*)(sl + 2 * 8192) + lane; const LAS bf16x8* T3 = (const LAS bf16x8*)(sl + 3 * 8192) + lane;
        f32x4 Oa[4]; const f32x4 zero4 = {0.f, 0.f, 0.f, 0.f};
        bf16x8 Sb[2]; Sb[0] = pack8(S[0], S[1]); Sb[1] = pack8(S[2], S[3]);
        bf16x8 fa[8], fb[8];
#pragma unroll
        for (int f = 0; f < 8; ++f) { fa[f] = T0[f * 64]; fb[f] = T1[f * 64]; }
        if (GDN) {
            f32x4 P[4]; bf16x4 uf[4];
#pragma unroll
            for (int mt = 0; mt < 4; ++mt) uf[mt] = *(const LAS bf16x4*)(sl + 4 * 8192 + ((mt * 4 + w) * 64 + lane) * 8);
            const float egl = *(const LAS float*)(sl + EOFF);
            __builtin_amdgcn_sched_barrier(0);
#pragma unroll
            for (int mt = 0; mt < 4; ++mt) { P[mt] = MFMA16(fa[mt * 2], Sb[0], zero4); Oa[mt] = MFMA16(fb[mt * 2], Sb[0], zero4); }
#pragma unroll
            for (int mt = 0; mt < 4; ++mt) { P[mt] = MFMA16(fa[mt * 2 + 1], Sb[1], P[mt]); Oa[mt] = MFMA16(fb[mt * 2 + 1], Sb[1], Oa[mt]); }
            __builtin_amdgcn_sched_barrier(0);
#pragma unroll
            for (int f = 0; f < 8; ++f) { fa[f] = T2[f * 64]; fb[f] = T3[f * 64]; }
            f32x4 vn[4];
#pragma unroll
            for (int mt = 0; mt < 4; ++mt) { vn[mt] = unpack4(uf[mt]) - P[mt]; S[mt] = S[mt] * egl; }
            bf16x8 vnb[2]; vnb[0] = pack8(vn[0], vn[1]); vnb[1] = pack8(vn[2], vn[3]);
            __builtin_amdgcn_sched_barrier(0);
#pragma unroll
            for (int mt = 0; mt < 4; ++mt) { Oa[mt] = MFMA16(fa[mt * 2], vnb[0], Oa[mt]); S[mt] = MFMA16(fb[mt * 2], vnb[0], S[mt]); }
#pragma unroll
            for (int mt = 0; mt < 4; ++mt) { Oa[mt] = MFMA16(fa[mt * 2 + 1], vnb[1], Oa[mt]); S[mt] = MFMA16(fb[mt * 2 + 1], vnb[1], S[mt]); }
        } else {
            bf16x8 fc[8]; bf16x8 Vb[2]; Vb[0] = *(const LAS bf16x8*)(sl + 3 * 8192 + (w * 64 + lane) * 16); Vb[1] = *(const LAS bf16x8*)(sl + 3 * 8192 + ((4 + w) * 64 + lane) * 16);
#pragma unroll
            for (int f = 0; f < 8; ++f) fc[f] = T2[f * 64];
            __builtin_amdgcn_sched_barrier(0);
#pragma unroll
            for (int mt = 0; mt < 4; ++mt) { Oa[mt] = MFMA16(fa[mt * 2], Sb[0], zero4); S[mt] = S[mt] * cd; }
#pragma unroll
            for (int mt = 0; mt < 4; ++mt) { Oa[mt] = MFMA16(fa[mt * 2 + 1], Sb[1], Oa[mt]); S[mt] = MFMA16(fc[mt * 2], Vb[0], S[mt]); }
#pragma unroll
            for (int mt = 0; mt < 4; ++mt) { Oa[mt] = MFMA16(fb[mt * 2], Vb[0], Oa[mt]); S[mt] = MFMA16(fc[mt * 2 + 1], Vb[1], S[mt]); }
#pragma unroll
            for (int mt = 0; mt < 4; ++mt) Oa[mt] = MFMA16(fb[mt * 2 + 1], Vb[1], Oa[mt]);
        }
        LAS float* ob = (LAS float*)(L + OUTB + (n & 1) * OUTSZ) + w * 16 + l15;
#pragma unroll
        for (int mt = 0; mt < 4; ++mt)
#pragma unroll
            for (int j = 0; j < 4; ++j) ob[(16 * mt + 4 * q + j) * 68] = Oa[mt][j];
    }
}
__device__ __forceinline__ void lru_seq_item(Frame& F, int b, int g, int n) {
    const int c = F.lane, ch = g * 64 + c;
    const float* SH = (const float*)((unsigned char*)(F.ws + WS_XB) + SC_LSH) + (size_t)(b * 128) * 384 + ch; const float* SA = (const float*)((unsigned char*)(F.ws + WS_XB) + SC_LSA) + (size_t)(b * 128) * 384 + ch;
    const bf16_t* P2 = ((const bf16_t*)(F.ws + WS_BIG)) + ((size_t)b * SEQL + n * 64) * DINP + C_LG + ch;
    bf16_t* op = ((bf16_t*)(F.ws + WS_O)) + ((size_t)b * SEQL + n * 64) * DM + O_L + ch;
    float carry = 0.f;
    int k = 0;
    for (; k + 8 <= n; k += 8) { float sh[8], sa[8];
#pragma unroll
        for (int i = 0; i < 8; ++i) { sh[i] = SH[(size_t)(k + i) * 384]; sa[i] = SA[(size_t)(k + i) * 384]; }
#pragma unroll
        for (int i = 0; i < 8; ++i) carry = sh[i] + sa[i] * carry; }
    for (; k < n; ++k) carry = SH[(size_t)k * 384] + SA[(size_t)k * 384] * carry;
#pragma unroll 1
    for (int t0 = 0; t0 < 64; t0 += 16) { bf16_t r1[16], r2[16];
#pragma unroll
        for (int i = 0; i < 16; ++i) { r1[i] = op[(size_t)(t0 + i) * DM]; r2[i] = P2[(size_t)(t0 + i) * DINP]; }
        __builtin_amdgcn_sched_barrier(0);
#pragma unroll
        for (int i = 0; i < 16; ++i) op[(size_t)(t0 + i) * DM] = (bf16_t)f2bf(bf2f(r1[i]) + bf2f(r2[i]) * carry); }
}
__device__ __forceinline__ void p_mix_seq(Frame& F, int l) {
    const int ci = F.bid;
    if (ci < 48) { const int b = ci / 6, h = ci % 6; seq_chain<true>(F, l, b, h); }
    else if (ci < 80) { const int v = ci - 48; const int b = v >> 2, h = v & 3; seq_chain<false>(F, l, b, h); }
    else { const int nwv = (F.G - 80) * 8;
        for (int item = (ci - 80) * 8 + F.wave; item < 6144; item += nwv) { const int n = item & 127, v = item >> 7; const int b = v / 6, g = v % 6; lru_seq_item(F, b, g, n); } }
}

#ifndef GMASK
#define GMASK 63
#endif
#define GSEL(b) ((GMASK & (b)) != 0)
__global__ void __launch_bounds__(512, 2) fwd(Args args) {
    extern __shared__ __attribute__((aligned(16))) unsigned char lds[];
    const int lo = args.ph_lo, hi = args.ph_hi;
    if (hi - lo > 1) cg::this_grid().sync();
    const int wv0 = __builtin_amdgcn_readfirstlane((int)threadIdx.x >> 6);
#ifdef PROBE_CAT
    if (threadIdx.x == 0) { volatile unsigned long long* ptm = (volatile unsigned long long*)(lds + 143360); ptm[0] = __builtin_amdgcn_s_memrealtime(); ptm[1] = 0ull; }
#endif
    for (int ph = lo; ph < hi; ++ph) {
        if (ph > lo) {
            asm volatile("s_waitcnt vmcnt(0) lgkmcnt(0)\n\ts_barrier" ::: "memory");
            unsigned zb_ = 0u; asm volatile("" : "+s"(zb_));
            if (wv0 == 0 && __builtin_amdgcn_mbcnt_hi(~0u, __builtin_amdgcn_mbcnt_lo(~0u, zb_)) == 0u) {
                __builtin_amdgcn_fence(__ATOMIC_RELEASE, "agent"); asm volatile("s_waitcnt vmcnt(0) lgkmcnt(0)" ::: "memory");
                unsigned* cnt = (unsigned*)args.ws + 2048 + 64 * ph;
                __hip_atomic_fetch_add(cnt, 1u, __ATOMIC_RELAXED, __HIP_MEMORY_SCOPE_AGENT);
                while (__hip_atomic_load(cnt, __ATOMIC_RELAXED, __HIP_MEMORY_SCOPE_AGENT) < gridDim.x) __builtin_amdgcn_s_sleep(1);
                __builtin_amdgcn_fence(__ATOMIC_ACQUIRE, "agent"); asm volatile("s_waitcnt vmcnt(0) lgkmcnt(0)" ::: "memory");
            }
            asm volatile("s_waitcnt vmcnt(0) lgkmcnt(0)\n\ts_barrier" ::: "memory");
        }
        Frame F;
        { unsigned z_ = 0u; asm volatile("" : "+s"(z_));
          int t_ = (wv0 << 6) | (int)__builtin_amdgcn_mbcnt_hi(~0u, __builtin_amdgcn_mbcnt_lo(~0u, z_)); asm volatile("" : "+v"(t_));
          const CAS Args* ap_ = (const CAS Args*)__builtin_amdgcn_kernarg_segment_ptr(); asm volatile("" : "+s"(ap_)); F.ap = ap_; GAS unsigned char* w_ = (GAS unsigned char*)ap_->ws;
          F.lds = (LAS unsigned char*)lds; F.ldsf = (float*)lds; F.tid = t_; F.lane = t_ & 63; F.wave = __builtin_amdgcn_readfirstlane(t_ >> 6); int g_ = gridDim.x, b_ = blockIdx.x; asm volatile("" : "+s"(g_), "+s"(b_)); F.G = g_; F.bid = b_; F.ws = w_; }
#ifdef PROBE_CAT
        if (threadIdx.x == 0) { volatile unsigned long long* ptm = (volatile unsigned long long*)(lds + 143360); const unsigned long long tn = __builtin_amdgcn_s_memrealtime(); const int pp = ph - 1;
          const int s_ = (pp - 1) & 7; const bool hit = (pp > 0) && (PROBE_CAT >= 10 ? (s_ == PROBE_CAT - 10) : (PROBE_CAT == 3 ? s_ == 3 : PROBE_CAT == 4 ? s_ == 4 : (s_ != 3 && s_ != 4)));
          if (hit || (PROBE_CAT == 0 && pp == 0)) ptm[1] += tn - ptm[0];
          ptm[0] = tn; }
        if (ph == NPH) {
            __syncthreads();
            if (blockIdx.x == 0) { volatile unsigned long long* ptm = (volatile unsigned long long*)(lds + 143360); const float v = __builtin_amdgcn_sqrtf((float)ptm[1] * 0.01f * 1.024e-6f);
                for (int i = threadIdx.x; i < 65536; i += 512) ((float*)(GAS float*)args.out)[i] += v; }
            break; }
#endif
        if (ph == 0) { p_prologue(F); continue; }
        const int l = (ph - 1) / 8, s = (ph - 1) % 8;
        unsigned char* wt = (unsigned char*)(F.ws + WS_WT);
        bf16_t* const XBp = (bf16_t*)((unsigned char*)(F.ws + WS_XB)); bf16_t* const BIGp = (bf16_t*)(F.ws + WS_BIG); bf16_t* const OBp = (bf16_t*)(F.ws + WS_O);
        float* const Xp = (float*)(GAS float*)F.ap->out;
        if (s == 0 || s == 6) {
            { pg8::Gemm g{XBp, (const bf16_t*)(wt + (s == 0 ? WT_GU1 : WT_GU2))}; pg8::StaticOrder S; S.init(M, 2 * DFF, F.G, F.bid);
              pg8::EpiGated<0> E{BIGp, DFF}; pg8::gemm_phase<XBLD, DM, DM>(F.lds, F.tid, g, S, E); }
            if (s == 6) { pg8::Gemm g{XBp, (const bf16_t*)(wt + WT_PLE)}; pg8::StaticOrder S; S.init(M, 2048, F.G, F.bid);
              pg8::EpiGated<1> E{OBp, DM}; pg8::gemm_phase<XBLD, XBLD, XBLD, pg8::EpiGated<1>, 16>(F.lds, F.tid, g, S, E); }
            if (l == 0 && s == 6) p_convert_weights(F, 1, 1);
            if (l == 1 && s == 0) p_convert_weights(F, 1, 2);
        } else if (s == 1 || s == 7 || s == 5) {
            const int k = (s == 1) ? 0 : (s == 5) ? 1 : 2;
            const float* lg = (const float*)(const GAS float*)F.ap->in[k == 0 ? 3 : k == 1 ? 22 : 29] + l * DM; const float* lb = (const float*)(const GAS float*)F.ap->in[k == 0 ? 4 : k == 1 ? 23 : 30] + l * DM;
            const float* resid_ = (ph == 2) ? (const float*)(const GAS float*)F.ap->in[0] : (const float*)Xp;
            const float* pin_ = (s == 5) ? (const float*)(const GAS float*)F.ap->in[1] + (size_t)l * M * 256 : (const float*)nullptr;
            unsigned long long* xbuf_ = (unsigned long long*)(F.ws + WS_XBUF); unsigned* cnt_ = (unsigned*)(F.ws + WS_LNCNT) + (size_t)(l * 3 + k) * 256 * 64;
            pg8::StaticOrder S; S.init(M, DM, F.G, F.bid);
            if (s == 5) { pg8::EpiResidLN<false> E{resid_, Xp, XBp, (const bf16_t*)nullptr, pin_, 1.0f, lg, lb, xbuf_, cnt_, F.lds + 131072};
                pg8::Gemm g{OBp, (const bf16_t*)(wt + WT_OUT)}; pg8::gemm_phase<DM, DM, DM>(F.lds, F.tid, g, S, E); }
            else if (s == 1) { pg8::EpiResidLN<false> E{resid_, Xp, XBp, (const bf16_t*)nullptr, pin_, 0.5f, lg, lb, xbuf_, cnt_, F.lds + 131072};
                pg8::Gemm g{BIGp, (const bf16_t*)(wt + WT_D1)}; pg8::gemm_phase<DFF, DFF, DFF>(F.lds, F.tid, g, S, E); }
            else { pg8::EpiResidLN<true> E{resid_, Xp, XBp, (const bf16_t*)OBp, pin_, 0.5f, lg, lb, xbuf_, cnt_, F.lds + 131072};
                pg8::Gemm g{BIGp, (const bf16_t*)(wt + WT_D2)}; pg8::gemm_phase<DFF, DFF, DFF>(F.lds, F.tid, g, S, E); }
        } else if (s == 2) {
            pg8::Gemm g{XBp, (const bf16_t*)(wt + WT_IN)}; pg8::StaticOrder S; S.init(M, DINP, F.G, F.bid);
            pg8::EpiBf16 E{BIGp, DINP}; pg8::gemm_phase<XBLD, DM, DM>(F.lds, F.tid, g, S, E);
        } else if (s == 3) { p_mix_par(F, l);
        } else if (s == 4) {
#if defined(PROBE_CAT) && PROBE_CAT == 99
            unsigned long long c0_ = __builtin_amdgcn_s_memrealtime();
#endif
            p_mix_seq(F, l);
#if defined(PROBE_CAT) && PROBE_CAT == 99
            __syncthreads(); if (F.tid == 0) { volatile unsigned long long* ptm = (volatile unsigned long long*)(lds + 143360); ptm[1] += __builtin_amdgcn_s_memrealtime() - c0_; }
#endif
        }
    }
}

extern "C" void kernel_launch(void* const* d_in, const int* in_sizes, int n_in, void* d_out, int out_size, void* d_ws, size_t ws_size, hipStream_t stream) {
    static int grid = 0;
    if (grid == 0) {
        if (n_in != 31 || out_size != M * DM || ws_size < WS_END) { fprintf(stderr, "kernel_launch: unexpected shapes (n_in %d out %d ws %zu)\n", n_in, out_size, ws_size); grid = -1; return; }
        int dev = 0, cus = 0;
        hipGetDevice(&dev); hipDeviceGetAttribute(&cus, hipDeviceAttributeMultiprocessorCount, dev);
        if (hipFuncSetAttribute((const void*)fwd, hipFuncAttributeMaxDynamicSharedMemorySize, LDS_BYTES) != hipSuccess) { fprintf(stderr, "hipFuncSetAttribute failed\n"); grid = -1; return; }
        int per_cu = 0; hipOccupancyMaxActiveBlocksPerMultiprocessor(&per_cu, (const void*)fwd, 512, LDS_BYTES); (void)hipGetLastError();
        grid = 256;
        if (cus < 256) { fprintf(stderr, "kernel_launch: needs 256 CUs with one resident 512-thread workgroup each (cus %d, occupancy query %d)\n", cus, per_cu); grid = -1; }
    }
    if (grid < 0) return;
    if (hipMemsetAsync(d_ws, 0, CTL_BYTES, stream) != hipSuccess) { fprintf(stderr, "memset failed\n"); return; }
    Args a{};
    for (int i = 0; i < 31; ++i) a.in[i] = d_in[i];
    a.out = (float*)d_out; a.ws = (unsigned char*)d_ws;
#if ONE_LAUNCH
#ifdef PROBE_CAT
    a.ph_lo = 0; a.ph_hi = NPH + 1;
#else
    a.ph_lo = 0; a.ph_hi = NPH;
#endif
    void* kargs[] = {&a};
    hipError_t e = hipLaunchCooperativeKernel((const void*)fwd, dim3(grid), dim3(512), kargs, LDS_BYTES, stream);
    if (e != hipSuccess) fprintf(stderr, "cooperative launch failed: %s\n", hipGetErrorString(e));
#else
    for (int ph = 0; ph < NPH; ++ph) { a.ph_lo = ph; a.ph_hi = ph + 1; hipLaunchKernelGGL(fwd, dim3(grid), dim3(512), LDS_BYTES, stream, a); }
#endif
}
```
